# Optimizing an MI355X kernel written in HIP

```python
import jax, jax.numpy as jnp
from jax import lax
import numpy as np


D_MODEL = 2048
BATCH = 4
SEQ = 2048
DEPTH = 1
DEC_BATCH = 32
DEC_SEQ = 32
PAST_LEN = 1024

CHUNK = 64
D_SB = D_MODEL // 2
SB_HEAD_DIM = 128
SB_HEADS = D_SB // SB_HEAD_DIM
D_CONV = D_MODEL // 2
CONV_W = 3
D_MIX = D_SB + D_CONV
D_IN = 4 * D_SB + 4 * D_CONV
Q_BLOCK = 128
EPS = 1e-6

kernel_name = 'stick_break_shortconv_hybrid_step'


def _rmsnorm(x, g):
    x32 = x.astype(jnp.float32)
    r = lax.rsqrt(jnp.mean(x32 * x32, axis=-1, keepdims=True) + EPS)
    return (x32 * r).astype(x.dtype) * g


def _project(h, w_in):
    proj = jnp.einsum('btd,de->bte', h, w_in)
    cuts = [D_SB, 2 * D_SB, 3 * D_SB, 4 * D_SB,
            4 * D_SB + D_CONV, 4 * D_SB + 2 * D_CONV, 4 * D_SB + 3 * D_CONV]
    q, k, v, g_sb, b, c, u, g_cv = jnp.split(proj, cuts, axis=-1)
    bsz, t = h.shape[0], h.shape[1]
    heads = lambda a: a.reshape(bsz, t, SB_HEADS, SB_HEAD_DIM)
    return heads(q), heads(k), heads(v), g_sb, b, c, u, g_cv


def _sb_attend(q, k, v, q_pos, k_pos):
    scale = SB_HEAD_DIM ** -0.5
    z = jnp.einsum('bqhd,bkhd->bhqk', q, k, preferred_element_type=jnp.float32) * scale
    mask = k_pos[None, :] < q_pos[:, None]
    log_beta = jax.nn.log_sigmoid(z)
    log_1m = jnp.where(mask, jax.nn.log_sigmoid(-z), 0.0)
    suffix = lax.cumsum(log_1m, axis=3, reverse=True) - log_1m
    w = jnp.where(mask, jnp.exp(log_beta + suffix), 0.0)
    return jnp.einsum('bhqk,bkhd->bqhd', w.astype(v.dtype), v)


def _sb_prompt(q, k, v):
    bsz, t = q.shape[0], q.shape[1]
    nb = t // Q_BLOCK
    qb = q.reshape(bsz, nb, Q_BLOCK, SB_HEADS, SB_HEAD_DIM).transpose(1, 0, 2, 3, 4)
    q_pos = jnp.arange(nb)[:, None] * Q_BLOCK + jnp.arange(Q_BLOCK)[None, :]
    k_pos = jnp.arange(t)
    ob = lax.map(lambda a: _sb_attend(a[0], k, v, a[1], k_pos), (qb, q_pos))
    return ob.transpose(1, 0, 2, 3, 4).reshape(bsz, t, SB_HEADS, SB_HEAD_DIM)


def _short_conv(b, cu, left, conv_w):
    t = cu.shape[1]
    full = jnp.concatenate([left.astype(cu.dtype), cu], axis=1)
    conv = conv_w[0] * full[:, 0:t]
    for i in range(1, CONV_W):
        conv = conv + conv_w[i] * full[:, i:i + t]
    return b * conv, full[:, t:]


def _merge(o_sb, g_sb, o_cv, g_cv, w_out):
    bsz, t = o_sb.shape[0], o_sb.shape[1]
    mix = jnp.concatenate([o_sb.reshape(bsz, t, D_SB) * jax.nn.silu(g_sb),
                           o_cv * jax.nn.silu(g_cv)], axis=-1)
    return jnp.einsum('bte,ed->btd', mix, w_out)


def _prompt_layer(x, norm_g, w_in, conv_w, w_out):
    h = _rmsnorm(x, norm_g)
    q, k, v, g_sb, b, c, u, g_cv = _project(h, w_in)
    o_sb = _sb_prompt(q, k, v)
    left = jnp.zeros((x.shape[0], CONV_W - 1, D_CONV), x.dtype)
    o_cv, conv_tail = _short_conv(b, c * u, left, conv_w)
    return x + _merge(o_sb, g_sb, o_cv, g_cv, w_out), k, v, conv_tail


def _sample_layer(x, k_past, v_past, conv_past, norm_g, w_in, conv_w, w_out):
    h = _rmsnorm(x, norm_g)
    q, k, v, g_sb, b, c, u, g_cv = _project(h, w_in)
    past, t = k_past.shape[1], x.shape[1]
    k_all = jnp.concatenate([k_past.astype(k.dtype), k], axis=1)
    v_all = jnp.concatenate([v_past.astype(v.dtype), v], axis=1)
    q_pos = past + jnp.arange(t)
    k_pos = jnp.arange(past + t)
    o_sb = _sb_attend(q, k_all, v_all, q_pos, k_pos)
    o_cv, conv_tail = _short_conv(b, c * u, conv_past, conv_w)
    return x + _merge(o_sb, g_sb, o_cv, g_cv, w_out), k, v, conv_tail


def setup_inputs(seed: int = 0) -> dict:
    key = jax.random.key(seed)
    ks = jax.random.split(key, 10)
    f32 = jnp.float32
    return {
        'x_prompt': jax.random.normal(ks[0], (BATCH, SEQ, D_MODEL), f32),
        'x_sample': jax.random.normal(ks[1], (DEC_BATCH, DEC_SEQ, D_MODEL), f32),
        'cache_k': jax.random.normal(ks[2], (DEPTH, DEC_BATCH, PAST_LEN, SB_HEADS, SB_HEAD_DIM), f32),
        'cache_v': jax.random.normal(ks[3], (DEPTH, DEC_BATCH, PAST_LEN, SB_HEADS, SB_HEAD_DIM), f32),
        'state_conv': jax.random.normal(ks[4], (DEPTH, DEC_BATCH, CONV_W - 1, D_CONV), f32),
        'norm_g': 1.0 + 0.01 * jax.random.normal(ks[5], (DEPTH, D_MODEL), f32),
        'w_in': jax.random.normal(ks[6], (DEPTH, D_MODEL, D_IN), f32) * D_MODEL ** -0.5,
        'conv_w': jax.random.normal(ks[7], (DEPTH, CONV_W, D_CONV), f32) * CONV_W ** -0.5,
        'w_out': jax.random.normal(ks[8], (DEPTH, D_MIX, D_MODEL), f32) * D_MIX ** -0.5,
        'final_g': 1.0 + 0.01 * jax.random.normal(ks[9], (D_MODEL,), f32),
    }


def reference(x_prompt, x_sample, cache_k, cache_v, state_conv, norm_g, w_in, conv_w, w_out, final_g):
    xp, xs = x_prompt, x_sample
    kp_l, vp_l, cp_l, ks_l, vs_l, cs_l = [], [], [], [], [], []
    for layer in range(DEPTH):
        xp, kp, vp, cp = _prompt_layer(xp, norm_g[layer], w_in[layer], conv_w[layer], w_out[layer])
        xs, kn, vn, cn = _sample_layer(xs, cache_k[layer], cache_v[layer], state_conv[layer],
                                       norm_g[layer], w_in[layer], conv_w[layer], w_out[layer])
        kp_l.append(kp); vp_l.append(vp); cp_l.append(cp)
        ks_l.append(kn); vs_l.append(vn); cs_l.append(cn)
    y_prompt = _rmsnorm(xp, final_g)
    y_sample = _rmsnorm(xs, final_g)
    return (y_prompt, y_sample, jnp.stack(kp_l), jnp.stack(vp_l), jnp.stack(cp_l),
            jnp.stack(ks_l), jnp.stack(vs_l), jnp.stack(cs_l))
```

```cpp
#include <hip/hip_runtime.h>
#include <cstdio>
#include <cstdint>

constexpr int DM = 2048;
constexpr int NB = 4, SEQ = 2048;
constexpr int DB = 32, DS = 32, PAST = 1024;
constexpr int MP = NB * SEQ;
constexpr int MS = DB * DS;
constexpr int MT = MP + MS;
constexpr int DIN = 8192;
constexpr int DH = 1024;
constexpr int NH = 8, HD = 128;
constexpr float EPS = 1e-6f;
constexpr float C2 = 0.08838834764831845f * 1.4426950408889634f;

constexpr size_t O_Y = 0;
constexpr size_t O_KP = (size_t)MT * DM;
constexpr size_t O_VP = O_KP + (size_t)MP * DH;
constexpr size_t O_CP = O_VP + (size_t)MP * DH;
constexpr size_t O_KS = O_CP + (size_t)NB * 2 * DH;
constexpr size_t O_VS = O_KS + (size_t)MS * DH;
constexpr size_t O_CS = O_VS + (size_t)MS * DH;
constexpr size_t O_END = O_CS + (size_t)DB * 2 * DH;

constexpr size_t MiB = 1u << 20;
constexpr size_t WS_CTL = 0, CTL_ZERO_BYTES = 1 * MiB;
constexpr size_t WS_WIN = 2 * MiB;
constexpr size_t WS_WOUT = 34 * MiB;
constexpr size_t WS_H = 42 * MiB;
constexpr size_t WS_Q = 78 * MiB, WS_K = 96 * MiB, WS_V = 114 * MiB, WS_GS = 132 * MiB, WS_CU = 150 * MiB, WS_BG = 168 * MiB;
constexpr size_t WS_MIX = 186 * MiB;
constexpr size_t WS_TMP = 224 * MiB;
constexpr size_t WS_END = 222 * MiB;

typedef unsigned short bf16;
#define GAS __attribute__((address_space(1)))
#define LAS __attribute__((address_space(3)))
#define NAIVE_P1 0
#define NAIVE_P2 0
#define NAIVE_P3 0
#define ONE_LAUNCH 0
namespace pg8 {
#define PG8_LAS __attribute__((address_space(3)))
typedef unsigned short bf16_t;
typedef short bf16x8 __attribute__((ext_vector_type(8)));
typedef float f32x4 __attribute__((ext_vector_type(4)));
typedef unsigned u32x4 __attribute__((ext_vector_type(4)));
constexpr int BM = 256, BK = 64, HALF = 128, HTB = HALF * BK * 2  , STAGE_BYTES = 8 * HTB, NXCD = 8, WGM = 8;

__host__ __device__ __forceinline__ int lds_byte(int r, int c) { const int st = (r >> 4) * 2 + (c >> 5), rr = r & 15, cc = c & 31, ob = rr * 64 + cc * 2; return st * 1024 + (ob ^ (((ob >> 9) & 1) << 5)); }
__host__ __device__ __forceinline__ void stage_rc(int b, int& R, int& C) { const int st = b / 1024, sb = b % 1024, swz = sb ^ (((sb >> 9) & 1) << 5); R = (st >> 1) * 16 + swz / 64; C = (st & 1) * 32 + (swz % 64) / 2; }
__host__ __device__ __forceinline__ int perm32(int rho) { const int n = rho >> 4, i = rho & 15; return 8 * (i >> 2) + 4 * n + (i & 3); }

struct Unit { int pm, pn; };
struct Gemm { const bf16_t* A; const bf16_t* Bt; int M, N, K; };

struct StaticOrder {
    int nM, nN, nwg, G, c;
    __host__ __device__ void init(int M, int N, int G_, int c_) { nM = M / BM; nN = N / BM; nwg = nM * nN; G = G_; c = c_; }
    __host__ __device__ bool next(int i, Unit& u) const {
        const long L = (long)i * G + c; if (L >= nwg) return false;
        int wgid = (int)L; { const int q = nwg / NXCD, r = nwg % NXCD, xcd = wgid % NXCD, off = wgid / NXCD; wgid = (xcd < r ? xcd * (q + 1) : r * (q + 1) + (xcd - r) * q) + off; }
        const int nig = WGM * nN, gid = wgid / nig, fm = gid * WGM, gsz = (nM - fm) < WGM ? (nM - fm) : WGM;
        u.pm = fm + ((wgid % nig) % gsz); u.pn = (wgid % nig) / gsz; return true;
    }
    __device__ __forceinline__ void a_ready(const Unit&) const {}
    __device__ __forceinline__ void done(const Unit&) const {}
};

typedef float f32x2_t __attribute__((ext_vector_type(2))); typedef __bf16 bf16x2_t __attribute__((ext_vector_type(2)));
__device__ __forceinline__ unsigned cvtpk(float lo, float hi) { f32x2_t v = {lo, hi}; bf16x2_t b = __builtin_convertvector(v, bf16x2_t); return __builtin_bit_cast(unsigned, b); }
__device__ __forceinline__ float silu_f(float x) { return x * __builtin_amdgcn_rcpf(1.0f + __builtin_amdgcn_exp2f(-1.4426950408889634f * x)); }
__device__ __forceinline__ f32x4 silu4(f32x4 v) { f32x4 o; o[0] = silu_f(v[0]); o[1] = silu_f(v[1]); o[2] = silu_f(v[2]); o[3] = silu_f(v[3]); return o; }

struct Epi1 {
    static constexpr bool PERM = true, AFTER_DRAIN = false;
    bf16_t *Qb, *Kb, *Vb, *Gs, *CU, *BG; float* out;
    __device__ __forceinline__ void operator()(const f32x4 (&acc)[2][2][4][2], const Unit& u, int wr, int wc, int fr, int fq) const {
        const int pn = u.pn, row0 = u.pm * BM + wr * 64 + fr, cl = wc * 32 + 8 * fq;
        if (pn < 16) {
            const int typ = pn >> 2, colb = (pn & 3) * 256 + cl;
            bf16_t* dst = typ == 0 ? Qb : (typ == 1 ? Kb : (typ == 2 ? Vb : Gs));
#pragma unroll
            for (int ai = 0; ai < 2; ++ai)
#pragma unroll
                for (int m = 0; m < 4; ++m) { const int row = row0 + ai * HALF + m * 16;
#pragma unroll
                    for (int bj = 0; bj < 2; ++bj) { const int col = colb + bj * HALF; f32x4 v0 = acc[ai][bj][m][0], v1 = acc[ai][bj][m][1];
                        if (typ == 0) { v0 = v0 * C2; v1 = v1 * C2; }
                        if (typ == 3) { v0 = silu4(v0); v1 = silu4(v1); }
                        if (typ == 1 || typ == 2) {
                            float* o = out + (row < MP ? (typ == 1 ? O_KP : O_VP) + (size_t)row * DH : (typ == 1 ? O_KS : O_VS) + (size_t)(row - MP) * DH) + col;
                            *(f32x4*)o = v0; *(f32x4*)(o + 4) = v1; }
                        u32x4 w; w.x = cvtpk(v0[0], v0[1]); w.y = cvtpk(v0[2], v0[3]); w.z = cvtpk(v1[0], v1[1]); w.w = cvtpk(v1[2], v1[3]);
                        *(u32x4*)(dst + (size_t)row * DH + col) = w; } }
        } else if (pn < 24) {
            const int chb = (pn - 16) * 128 + cl;
#pragma unroll
            for (int ai = 0; ai < 2; ++ai)
#pragma unroll
                for (int m = 0; m < 4; ++m) { const int row = row0 + ai * HALF + m * 16;
                    const f32x4 v0 = acc[ai][0][m][0] * acc[ai][1][m][0], v1 = acc[ai][0][m][1] * acc[ai][1][m][1];
                    u32x4 w; w.x = cvtpk(v0[0], v0[1]); w.y = cvtpk(v0[2], v0[3]); w.z = cvtpk(v1[0], v1[1]); w.w = cvtpk(v1[2], v1[3]);
                    *(u32x4*)(CU + (size_t)row * DH + chb) = w;
                    if (row < MP) { const int t = row & (SEQ - 1); if (t >= SEQ - 2) { float* o = out + O_CP + (size_t)((row >> 11) * 2 + (t - (SEQ - 2))) * DH + chb; *(f32x4*)o = v0; *(f32x4*)(o + 4) = v1; } }
                    else { const int r2 = row - MP, t = r2 & (DS - 1); if (t >= DS - 2) { float* o = out + O_CS + (size_t)((r2 >> 5) * 2 + (t - (DS - 2))) * DH + chb; *(f32x4*)o = v0; *(f32x4*)(o + 4) = v1; } } }
        } else {
            const int chb = (pn - 24) * 128 + cl;
#pragma unroll
            for (int ai = 0; ai < 2; ++ai)
#pragma unroll
                for (int m = 0; m < 4; ++m) { const int row = row0 + ai * HALF + m * 16;
                    const f32x4 v0 = acc[ai][0][m][0] * silu4(acc[ai][1][m][0]), v1 = acc[ai][0][m][1] * silu4(acc[ai][1][m][1]);
                    u32x4 w; w.x = cvtpk(v0[0], v0[1]); w.y = cvtpk(v0[2], v0[3]); w.z = cvtpk(v1[0], v1[1]); w.w = cvtpk(v1[2], v1[3]);
                    *(u32x4*)(BG + (size_t)row * DH + chb) = w; }
        }
    }
};
struct Epi2 {
    static constexpr bool PERM = false, AFTER_DRAIN = false;
    const float* xp; const float* xs; float* y;
    __device__ __forceinline__ void operator()(const f32x4 (&acc)[2][2][4][2], const Unit& u, int wr, int wc, int fr, int fq) const {
        const int row0 = u.pm * BM + wr * 64 + fr, col0 = u.pn * BM + wc * 32 + 4 * fq;
#pragma unroll
        for (int ai = 0; ai < 2; ++ai)
#pragma unroll
            for (int m = 0; m < 4; ++m) { const int row = row0 + ai * HALF + m * 16;
                const float* xr = row < MP ? xp + (size_t)row * DM : xs + (size_t)(row - MP) * DM; float* yr = y + (size_t)row * DM;
#pragma unroll
                for (int bj = 0; bj < 2; ++bj)
#pragma unroll
                    for (int n = 0; n < 2; ++n) { const int col = col0 + bj * HALF + n * 16; *(f32x4*)(yr + col) = acc[ai][bj][m][n] + *(const f32x4*)(xr + col); } }
    }
};

template <class Epi, class Sched, bool ALIGN_EPI = false, bool SP2 = false>
__device__ __forceinline__ void gemm_phase(PG8_LAS unsigned char* lds, const Gemm g, const Sched& S, const Epi& E) {
    const int tid = threadIdx.x, wid = __builtin_amdgcn_readfirstlane(tid >> 6), lane = tid & 63, wr = wid >> 2, wc = wid & 3, fr = lane & 15, fq = lane >> 4;
    const int K = g.K, nt = K / BK;
    unsigned voffA[2], voffB[2];
#pragma unroll
    for (int i = 0; i < 2; ++i) { int R, C; stage_rc(tid * 16 + i * 8192, R, C); const int Rb = Epi::PERM ? ((R & ~31) + perm32(R & 31)) : R;
        voffA[i] = (unsigned)(R * K + C) * 2u; voffB[i] = (unsigned)(Rb * K + C) * 2u; }
    const size_t kstep = (size_t)(BK * 2);
    const size_t hstep = (size_t)HALF * K * 2;
    const size_t tstep = 2 * hstep;
    const unsigned ldsw = (unsigned)wid * 1024u;
    const int aoff = lds_byte(wr * 64 + fr, fq * 8), boff = lds_byte(wc * 32 + fr, fq * 8);
#define PG8_SA(b, h) (((b) * 2 + (h)) * HTB)
#define PG8_SB(b, h) ((4 + (b) * 2 + (h)) * HTB)
#define PG8_STAGE(bufoff, gbase, voff) do { _Pragma("unroll") for (int _i = 0; _i < 2; ++_i) \
        __builtin_amdgcn_global_load_lds((const unsigned*)((const char*)(gbase) + (voff)[_i]), (PG8_LAS unsigned*)(lds + (bufoff) + ldsw + _i * 8192), 16, 0, 0); } while (0)
#define PG8_LDA(dst, b, h) do { _Pragma("unroll") for (int m = 0; m < 4; ++m) _Pragma("unroll") for (int k = 0; k < 2; ++k) dst[m][k] = *(const PG8_LAS bf16x8*)(lds + PG8_SA(b, h) + aoff + m * 2048 + k * 1024); } while (0)
#define PG8_LDB(dst, b, h) do { _Pragma("unroll") for (int n = 0; n < 2; ++n) _Pragma("unroll") for (int k = 0; k < 2; ++k) dst[n][k] = *(const PG8_LAS bf16x8*)(lds + PG8_SB(b, h) + boff + n * 2048 + k * 1024); } while (0)
#define PG8_MMA(ai, bj, At, Bt) do { __builtin_amdgcn_s_setprio(1); _Pragma("unroll") for (int m = 0; m < 4; ++m) _Pragma("unroll") for (int n = 0; n < 2; ++n) _Pragma("unroll") for (int k = 0; k < 2; ++k) \
        acc[ai][bj][m][n] = __builtin_amdgcn_mfma_f32_16x16x32_bf16(Bt[n][k], At[m][k], acc[ai][bj][m][n], 0, 0, 0); __builtin_amdgcn_s_setprio(0); } while (0)
#define PG8_WAIT_V(n) asm volatile("s_waitcnt vmcnt(" #n ")" ::: "memory")
#define PG8_WAIT_L(n) asm volatile("s_waitcnt lgkmcnt(" #n ")" ::: "memory")
#define PG8_BAR __builtin_amdgcn_s_barrier()
#define PG8_SCHED __builtin_amdgcn_sched_barrier(0)
    Unit cur, nxt; int ui = 0;
    if (!S.next(0, cur)) return;
    f32x4 acc[2][2][4][2];
#pragma unroll
    for (int a = 0; a < 2; ++a)
#pragma unroll
        for (int b = 0; b < 2; ++b)
#pragma unroll
            for (int m = 0; m < 4; ++m)
#pragma unroll
                for (int n = 0; n < 2; ++n) acc[a][b][m][n] = (f32x4){0.f, 0.f, 0.f, 0.f};
    bf16x8 At[4][2], B0[2][2], B1[2][2];
    const char* cA = (const char*)g.A + (size_t)cur.pm * tstep; const char* cB = (const char*)g.Bt + (size_t)cur.pn * tstep;
    S.a_ready(cur);
    if constexpr (SP2) {
        PG8_STAGE(PG8_SB(0, 0), cB, voffB); PG8_STAGE(PG8_SB(0, 1), cB + hstep, voffB); PG8_STAGE(PG8_SA(0, 0), cA, voffA); PG8_STAGE(PG8_SA(0, 1), cA + hstep, voffA);
        if (wr == 1) PG8_BAR;
        PG8_WAIT_V(2); PG8_BAR;
        PG8_STAGE(PG8_SB(1, 0), cB + kstep, voffB); PG8_STAGE(PG8_SA(1, 0), cA + kstep, voffA); PG8_STAGE(PG8_SB(1, 1), cB + hstep + kstep, voffB);
        PG8_WAIT_V(6); PG8_BAR;
    } else {
        PG8_STAGE(PG8_SB(0, 0), cB, voffB); PG8_STAGE(PG8_SA(0, 0), cA, voffA); PG8_STAGE(PG8_SB(0, 1), cB + hstep, voffB); PG8_STAGE(PG8_SA(0, 1), cA + hstep, voffA);
        if (wr == 1) PG8_BAR;
        PG8_WAIT_V(4); PG8_BAR;
        PG8_STAGE(PG8_SB(1, 0), cB + kstep, voffB); PG8_STAGE(PG8_SA(1, 0), cA + kstep, voffA); PG8_STAGE(PG8_SB(1, 1), cB + hstep + kstep, voffB);
        PG8_WAIT_V(6); PG8_BAR;
    }
    for (;;) {
        const bool has_next = S.next(ui + 1, nxt);
        const char* nA = has_next ? (const char*)g.A + (size_t)nxt.pm * tstep : cA; const char* nB = has_next ? (const char*)g.Bt + (size_t)nxt.pn * tstep : cB;
        for (int t = 0; t < nt; t += 2) {
            const bool last = (t == nt - 2);
            const char* a1 = cA + (size_t)(t + 1) * kstep;
            const char* a2 = last ? nA : cA + (size_t)(t + 2) * kstep; const char* b2 = last ? nB : cB + (size_t)(t + 2) * kstep;
            const char* a3 = a2 + kstep; const char* b3 = b2 + kstep;
            if (last && has_next) S.a_ready(nxt);
            if constexpr (SP2) {
            PG8_LDB(B0, 0, 0); PG8_LDB(B1, 0, 1); PG8_SCHED; PG8_LDA(At, 0, 0); PG8_STAGE(PG8_SA(1, 1), a1 + hstep, voffA);
            PG8_WAIT_V(8); PG8_WAIT_L(0); PG8_BAR; PG8_MMA(0, 0, At, B0); PG8_MMA(0, 1, At, B1); PG8_BAR; PG8_SCHED;
            PG8_LDA(At, 0, 1); PG8_STAGE(PG8_SB(0, 0), b2, voffB); PG8_STAGE(PG8_SB(0, 1), b2 + hstep, voffB); PG8_STAGE(PG8_SA(0, 0), a2, voffA);
            PG8_WAIT_V(8); PG8_WAIT_L(0); PG8_BAR; PG8_MMA(1, 0, At, B0); PG8_MMA(1, 1, At, B1); PG8_BAR; PG8_SCHED;
            PG8_LDB(B0, 1, 0); PG8_LDB(B1, 1, 1); PG8_SCHED; PG8_LDA(At, 1, 0); PG8_STAGE(PG8_SA(0, 1), a2 + hstep, voffA);
            PG8_WAIT_V(8); PG8_WAIT_L(0); PG8_BAR; PG8_MMA(0, 0, At, B0); PG8_MMA(0, 1, At, B1); PG8_BAR; PG8_SCHED;
            PG8_LDA(At, 1, 1); PG8_STAGE(PG8_SB(1, 0), b3, voffB); PG8_STAGE(PG8_SB(1, 1), b3 + hstep, voffB); PG8_STAGE(PG8_SA(1, 0), a3, voffA);
            PG8_WAIT_V(8); PG8_WAIT_L(0); PG8_BAR; PG8_MMA(1, 0, At, B0); PG8_MMA(1, 1, At, B1); PG8_BAR; PG8_SCHED;
            } else {
            PG8_LDB(B0, 0, 0); PG8_SCHED; PG8_LDA(At, 0, 0); PG8_STAGE(PG8_SA(1, 1), a1 + hstep, voffA);
            PG8_WAIT_L(8); PG8_BAR; PG8_WAIT_L(0); PG8_MMA(0, 0, At, B0); PG8_BAR; PG8_SCHED;
            PG8_LDB(B1, 0, 1); PG8_STAGE(PG8_SB(0, 0), b2, voffB);
            PG8_BAR; PG8_WAIT_L(0); PG8_MMA(0, 1, At, B1); PG8_BAR;
            PG8_LDA(At, 0, 1); PG8_STAGE(PG8_SA(0, 0), a2, voffA);
            PG8_BAR; PG8_WAIT_L(0); PG8_MMA(1, 0, At, B0); PG8_BAR; PG8_SCHED;
            PG8_STAGE(PG8_SB(0, 1), b2 + hstep, voffB);
            PG8_WAIT_V(6); PG8_BAR; PG8_MMA(1, 1, At, B1); PG8_BAR;
            PG8_LDB(B0, 1, 0); PG8_SCHED; PG8_LDA(At, 1, 0); PG8_STAGE(PG8_SA(0, 1), a2 + hstep, voffA);
            PG8_WAIT_L(8); PG8_BAR; PG8_WAIT_L(0); PG8_MMA(0, 0, At, B0); PG8_BAR; PG8_SCHED;
            PG8_LDB(B1, 1, 1); PG8_STAGE(PG8_SB(1, 0), b3, voffB);
            PG8_BAR; PG8_WAIT_L(0); PG8_MMA(0, 1, At, B1); PG8_BAR;
            PG8_LDA(At, 1, 1); PG8_STAGE(PG8_SA(1, 0), a3, voffA);
            PG8_BAR; PG8_WAIT_L(0); PG8_MMA(1, 0, At, B0); PG8_BAR; PG8_SCHED;
            PG8_STAGE(PG8_SB(1, 1), b3 + hstep, voffB);
            PG8_WAIT_V(6); PG8_BAR; PG8_MMA(1, 1, At, B1); PG8_BAR;
            }
        }
        if constexpr (ALIGN_EPI) { if (wr == 0) PG8_BAR; }
        if constexpr (!Epi::AFTER_DRAIN) { E(acc, cur, wr, wc, fr, fq); S.done(cur); }
        if (!has_next) break;
#pragma unroll
        for (int a = 0; a < 2; ++a)
#pragma unroll
            for (int b = 0; b < 2; ++b)
#pragma unroll
                for (int m = 0; m < 4; ++m)
#pragma unroll
                    for (int n = 0; n < 2; ++n) acc[a][b][m][n] = (f32x4){0.f, 0.f, 0.f, 0.f};
        cur = nxt; cA = nA; cB = nB; ++ui;
        if constexpr (ALIGN_EPI) { if (wr == 1) PG8_BAR; }
    }
    PG8_WAIT_V(0);
    if constexpr (!ALIGN_EPI) { if (wr == 0) PG8_BAR; }
    PG8_BAR;
    if constexpr (Epi::AFTER_DRAIN) { E.fused(acc, cur, wr, wc, fr, fq, lds, wid, lane); S.done(cur); }
#undef PG8_SA
#undef PG8_SB
#undef PG8_STAGE
#undef PG8_LDA
#undef PG8_LDB
#undef PG8_MMA
#undef PG8_WAIT_V
#undef PG8_WAIT_L
#undef PG8_BAR
#undef PG8_SCHED
}
}
constexpr int NWAVES = 8;
constexpr int RING_OFF = 0, RING_BYTES = 131072;
constexpr int LDSCTL_OFF = 155648, MISC_OFF = LDSCTL_OFF + 320;
constexpr int XCH_OFF = LDSCTL_OFF + 1024;
constexpr int LDS_BYTES = 159744;
static_assert(XCH_OFF + 1024 <= LDS_BYTES && MISC_OFF + 128 <= XCH_OFF, "LDS map");

typedef unsigned v4u __attribute__((ext_vector_type(4)));
typedef unsigned v2u __attribute__((ext_vector_type(2)));
typedef float f32x4 __attribute__((ext_vector_type(4)));
typedef short bf16x8 __attribute__((ext_vector_type(8)));
typedef short s16x4 __attribute__((ext_vector_type(4)));
typedef float f32x16 __attribute__((ext_vector_type(16)));
typedef GAS unsigned gu32;
#define RLX_AGENT __ATOMIC_RELAXED, __HIP_MEMORY_SCOPE_AGENT
#define LDS_WAIT() asm volatile("s_waitcnt lgkmcnt(0)" ::: "memory")
#define VM_WAIT() asm volatile("s_waitcnt vmcnt(0)" ::: "memory")
#define CFENCE() do { asm volatile("" ::: "memory"); __builtin_amdgcn_wave_barrier(); asm volatile("" ::: "memory"); } while (0)
using pg8::cvtpk;
__device__ __forceinline__ float bf2f(unsigned b) { return __uint_as_float(b << 16); }
__device__ __forceinline__ float bflo(unsigned w) { return __uint_as_float(w << 16); }
__device__ __forceinline__ float bfhi(unsigned w) { return __uint_as_float(w & 0xffff0000u); }

#define XB_TMO      128
#define XB_XCNT(j)  (256  + 64 * (j))
#define XB_XSUB(j)  (1280 + 64 * (j))
#define XB_XGEN(j)  (2304 + 64 * (j))
#define XB_TOP      3328
#define XB_TOPGEN   3392
#define XCD_BAR_WORDS 3456
#define XB_SPIN_CAP (1u << 18)

__device__ __forceinline__ unsigned xb_ld(unsigned* p)              { return __hip_atomic_load(p, __ATOMIC_RELAXED, __HIP_MEMORY_SCOPE_AGENT); }
__device__ __forceinline__ unsigned xb_add(unsigned* p, unsigned v) { return __hip_atomic_fetch_add(p, v, __ATOMIC_RELAXED, __HIP_MEMORY_SCOPE_AGENT); }
__device__ __forceinline__ unsigned xb_xcc_id() { return (unsigned)__builtin_amdgcn_s_getreg((3 << 11) | 20) & 0xFu; }
#define XB_SPIN(cond, bar) do { unsigned _sp = 0; while (cond) { __builtin_amdgcn_s_sleep(1); \
    if ((++_sp & 255u) == 0u) { if (xb_ld(&(bar)[XB_TMO])) break; if (_sp > XB_SPIN_CAP) { atomicAdd(&(bar)[XB_TMO], 1u); break; } } } } while (0)

struct XcdBarrier {
    unsigned* bar; unsigned x;
    volatile LAS unsigned* st;
};

__device__ __forceinline__ XcdBarrier xcd_barrier_post(unsigned* bar, volatile LAS unsigned* st) {
    XcdBarrier b; b.bar = bar; b.x = xb_xcc_id(); b.st = st;
    if (threadIdx.x == 0) (void)xb_add(&bar[XB_XCNT(b.x)], 1u);
    return b;
}
__device__ __forceinline__ void xcd_barrier_complete(unsigned* bar, unsigned x, unsigned& nloc, unsigned& nx) {
    const unsigned G = gridDim.x * gridDim.y * gridDim.z;
    unsigned sum, cnt, mine, sp = 0u;
    for (;;) {
        sum = 0u; cnt = 0u; mine = 0u;
#pragma unroll
        for (unsigned j = 0; j < 16; ++j) { const unsigned c = xb_ld(&bar[XB_XCNT(j)]); sum += c; cnt += (c > 0u) ? 1u : 0u; mine = (j == x) ? c : mine; }
        if (sum == G) break;
        __builtin_amdgcn_s_sleep(1);
        if ((++sp & 255u) == 0u) { if (xb_ld(&bar[XB_TMO])) break; if (sp > XB_SPIN_CAP) { atomicAdd(&bar[XB_TMO], 1u); break; } }
    }
    nloc = mine > 0u ? mine : 1u; nx = cnt > 0u ? cnt : 1u;
}

__device__ __forceinline__ void xcd_barrier(const XcdBarrier& b) {
    asm volatile("s_waitcnt vmcnt(0)" ::: "memory");
    __syncthreads();
    if (threadIdx.x == 0) {
        unsigned* bar = b.bar;
        __builtin_amdgcn_s_waitcnt(0);
        unsigned nloc = b.st[0], nx = b.st[1];
        if (nloc == 0u) { xcd_barrier_complete(bar, b.x, nloc, nx); b.st[0] = nloc; b.st[1] = nx; }
        const unsigned old = xb_add(&bar[XB_XSUB(b.x)], 1u);
        const unsigned gen = old / nloc;
        if (old + 1u == (gen + 1u) * nloc) {
            __builtin_amdgcn_fence(__ATOMIC_RELEASE, "agent");
            asm volatile("s_waitcnt vmcnt(0)" ::: "memory");
            const unsigned og = xb_add(&bar[XB_TOP], 1u);
            const unsigned tg = og / nx;
            if (og + 1u == (tg + 1u) * nx) xb_add(&bar[XB_TOPGEN], 1u);
            else XB_SPIN(xb_ld(&bar[XB_TOPGEN]) == tg, bar);
            __builtin_amdgcn_fence(__ATOMIC_ACQUIRE, "agent");
            xb_add(&bar[XB_XGEN(b.x)], 1u);
            asm volatile("s_waitcnt vmcnt(0)" ::: "memory");
        } else {
            XB_SPIN(xb_ld(&bar[XB_XGEN(b.x)]) == gen, bar);
            __builtin_amdgcn_fence(__ATOMIC_ACQUIRE, "agent");
            asm volatile("s_waitcnt vmcnt(0)" ::: "memory");
        }
    }
    __syncthreads();
}

struct Frame {
    LAS unsigned char* lds;
    volatile LAS unsigned* MISC;
    gu32* ctl;
    int tid, lane, wave;
    int vcu, G;
    const float *xp, *xs, *ck, *cv, *sconv, *norm_g, *w_in, *conv_w, *w_out, *final_g; float* out;
    bf16 *Win_t, *Wout_t, *H, *Qb, *Kb, *Vb, *Gs, *CU, *BG, *MIX;
};

__device__ __forceinline__ float wave_sum(float v) {
#pragma unroll
    for (int o = 1; o < 64; o <<= 1) v += __shfl_xor(v, o);
    return v;
}
__device__ __forceinline__ void p0_transpose_item(const float* W, int K, int N, bf16* WT, int k0, int n0, int drow0, LAS float* scr, int lane) {
#pragma unroll 8
    for (int i = 0; i < 32; ++i) { const int kk = 2 * i + (lane >> 5); scr[kk * 33 + (lane & 31)] = W[(size_t)(k0 + kk) * N + n0 + (lane & 31)]; }
    LDS_WAIT(); CFENCE();
    const int c = lane & 7;
#pragma unroll
    for (int j = 0; j < 4; ++j) { const int n = (lane >> 3) + 8 * j; const LAS float* s = scr + (8 * c) * 33 + n;
        v4u o; o.x = cvtpk(s[0 * 33], s[1 * 33]); o.y = cvtpk(s[2 * 33], s[3 * 33]); o.z = cvtpk(s[4 * 33], s[5 * 33]); o.w = cvtpk(s[6 * 33], s[7 * 33]);
        *(GAS v4u*)(WT + (size_t)(drow0 + n) * K + k0 + 8 * c) = o; }
    LDS_WAIT(); CFENCE();
}
__device__ __forceinline__ int win_dest_row(int n) {
    if (n < 4096) return n;
    const int s = (n - 4096) >> 10, ch = (n - 4096) & 1023, j = ch >> 7, cc = ch & 127;
    const int tile = (s == 1 || s == 2) ? 16 + j : 24 + j, half = (s == 2 || s == 3) ? 128 : 0;
    return tile * 256 + half + cc;
}
__device__ __forceinline__ void rms_row_to_bf16(const float* xrow, const float* g, bf16* orow, int lane) {
    const GAS f32x4* xr = (const GAS f32x4*)xrow + lane; const GAS f32x4* gr = (const GAS f32x4*)g + lane;
    f32x4 v[8]; float s = 0.f;
#pragma unroll
    for (int j = 0; j < 8; ++j) { v[j] = xr[64 * j]; s += (v[j].x * v[j].x + v[j].y * v[j].y) + (v[j].z * v[j].z + v[j].w * v[j].w); }
    const float r = 1.0f / sqrtf(wave_sum(s) * (1.f / DM) + EPS);
    GAS v2u* o8 = (GAS v2u*)orow + lane;
#pragma unroll
    for (int j = 0; j < 8; ++j) { const f32x4 gg = gr[64 * j]; v2u w; w.x = cvtpk((v[j].x * r) * gg.x, (v[j].y * r) * gg.y); w.y = cvtpk((v[j].z * r) * gg.z, (v[j].w * r) * gg.w); o8[64 * j] = w; }
}
__device__ __forceinline__ void p0_prologue(Frame& F) {
    LAS float* scr = (LAS float*)(F.lds + RING_OFF + F.wave * 16384);
    const int gw = F.vcu * NWAVES + F.wave, NGW = F.G * NWAVES;
    constexpr int I_IN = (DM / 64) * (DIN / 32), I_OUT = (DM / 64) * (DM / 32);
    for (int it = gw; it < I_IN + I_OUT; it += NGW) {
        if (it < I_IN) { const int kb = it / (DIN / 32), nb = it % (DIN / 32); p0_transpose_item(F.w_in, DM, DIN, F.Win_t, 64 * kb, 32 * nb, win_dest_row(32 * nb), scr, F.lane); }
        else { const int r = it - I_IN, kb = r / (DM / 32), nb = r % (DM / 32); p0_transpose_item(F.w_out, DM, DM, F.Wout_t, 64 * kb, 32 * nb, 32 * nb, scr, F.lane); }
    }
    for (int m = gw; m < MT; m += NGW) rms_row_to_bf16(m < MP ? F.xp + (size_t)m * DM : F.xs + (size_t)(m - MP) * DM, F.norm_g, F.H + (size_t)m * DM, F.lane);
}
__device__ __forceinline__ void p4_final_norm(Frame& F) {
    const int gw = F.vcu * NWAVES + F.wave, NGW = F.G * NWAVES;
    for (int m = gw; m < MT; m += NGW) {
        GAS f32x4* yr = (GAS f32x4*)(F.out + O_Y + (size_t)m * DM) + F.lane; const GAS f32x4* gr = (const GAS f32x4*)F.final_g + F.lane;
        f32x4 v[8]; float s = 0.f;
#pragma unroll
        for (int j = 0; j < 8; ++j) { v[j] = yr[64 * j]; s += (v[j].x * v[j].x + v[j].y * v[j].y) + (v[j].z * v[j].z + v[j].w * v[j].w); }
        const float r = 1.0f / sqrtf(wave_sum(s) * (1.f / DM) + EPS);
#pragma unroll
        for (int j = 0; j < 8; ++j) { const f32x4 gg = gr[64 * j]; f32x4 o; o.x = (v[j].x * r) * gg.x; o.y = (v[j].y * r) * gg.y; o.z = (v[j].z * r) * gg.z; o.w = (v[j].w * r) * gg.w; yr[64 * j] = o; }
    }
}
__device__ __forceinline__ void unpack8(const v4u w, float (&f)[8]) { f[0] = bflo(w.x); f[1] = bfhi(w.x); f[2] = bflo(w.y); f[3] = bfhi(w.y); f[4] = bflo(w.z); f[5] = bfhi(w.z); f[6] = bflo(w.w); f[7] = bfhi(w.w); }
__device__ __forceinline__ void p2_convmix(Frame& F) {
    const int gw = F.vcu * NWAVES + F.wave, NGW = F.G * NWAVES;
    for (int item = gw; item < MT * 2; item += NGW) {
        const int row = item >> 1, ch = (item & 1) * 512 + F.lane * 8;
        const bool samp = row >= MP; const int t = samp ? ((row - MP) & (DS - 1)) : (row & (SEQ - 1)); const int b = samp ? ((row - MP) >> 5) : (row >> 11);
        float c0[8], c1[8], c2[8], g[8];
        unpack8(*(const GAS v4u*)(F.CU + (size_t)row * DH + ch), c0);
        unpack8(*(const GAS v4u*)(F.BG + (size_t)row * DH + ch), g);
        if (t >= 1) unpack8(*(const GAS v4u*)(F.CU + (size_t)(row - 1) * DH + ch), c1);
        else if (samp) { const f32x4 a = *(const GAS f32x4*)(F.sconv + (size_t)(b * 2 + 1) * DH + ch), bq = *(const GAS f32x4*)(F.sconv + (size_t)(b * 2 + 1) * DH + ch + 4);
            c1[0] = a.x; c1[1] = a.y; c1[2] = a.z; c1[3] = a.w; c1[4] = bq.x; c1[5] = bq.y; c1[6] = bq.z; c1[7] = bq.w; }
        else {
#pragma unroll
            for (int i = 0; i < 8; ++i) c1[i] = 0.f; }
        if (t >= 2) unpack8(*(const GAS v4u*)(F.CU + (size_t)(row - 2) * DH + ch), c2);
        else if (samp) { const f32x4 a = *(const GAS f32x4*)(F.sconv + (size_t)(b * 2 + t) * DH + ch), bq = *(const GAS f32x4*)(F.sconv + (size_t)(b * 2 + t) * DH + ch + 4);
            c2[0] = a.x; c2[1] = a.y; c2[2] = a.z; c2[3] = a.w; c2[4] = bq.x; c2[5] = bq.y; c2[6] = bq.z; c2[7] = bq.w; }
        else {
#pragma unroll
            for (int i = 0; i < 8; ++i) c2[i] = 0.f; }
        float w0[8], w1[8], w2[8];
        { const GAS f32x4* p = (const GAS f32x4*)(F.conv_w + ch); const f32x4 a = p[0], bq = p[1]; w0[0] = a.x; w0[1] = a.y; w0[2] = a.z; w0[3] = a.w; w0[4] = bq.x; w0[5] = bq.y; w0[6] = bq.z; w0[7] = bq.w; }
        { const GAS f32x4* p = (const GAS f32x4*)(F.conv_w + DH + ch); const f32x4 a = p[0], bq = p[1]; w1[0] = a.x; w1[1] = a.y; w1[2] = a.z; w1[3] = a.w; w1[4] = bq.x; w1[5] = bq.y; w1[6] = bq.z; w1[7] = bq.w; }
        { const GAS f32x4* p = (const GAS f32x4*)(F.conv_w + 2 * DH + ch); const f32x4 a = p[0], bq = p[1]; w2[0] = a.x; w2[1] = a.y; w2[2] = a.z; w2[3] = a.w; w2[4] = bq.x; w2[5] = bq.y; w2[6] = bq.z; w2[7] = bq.w; }
        float o[8];
#pragma unroll
        for (int i = 0; i < 8; ++i) o[i] = g[i] * ((w0[i] * c2[i] + w1[i] * c1[i]) + w2[i] * c0[i]);
        v4u w; w.x = cvtpk(o[0], o[1]); w.y = cvtpk(o[2], o[3]); w.z = cvtpk(o[4], o[5]); w.w = cvtpk(o[6], o[7]);
        *(GAS v4u*)(F.MIX + (size_t)row * DM + DH + ch) = w;
    }
}

namespace sb {
constexpr float EXIT_THR = -160.0f;
constexpr int KST = 272, VST = 320;
constexpr int QIMG_OFF = 32 * VST;
constexpr int ATT_REGION = 19456;
static_assert(QIMG_OFF + 32 * KST <= ATT_REGION && 8 * ATT_REGION <= LDSCTL_OFF, "attention LDS map");
typedef __amdgpu_buffer_rsrc_t rsrc_t;
__device__ __forceinline__ rsrc_t mk_rsrc(const void* p, unsigned bytes) { return __builtin_amdgcn_make_buffer_rsrc((void*)p, (short)0, (int)bytes, 0x00020000); }
__device__ __forceinline__ int crow(int r, int hi) { return (r & 3) + 8 * (r >> 2) + 4 * hi; }
__device__ __forceinline__ s16x4 vtr(LAS const char* p) { typedef short v4i16_t __attribute__((ext_vector_type(4))); return __builtin_bit_cast(s16x4, __builtin_amdgcn_ds_read_tr16_b64_v4i16((LAS v4i16_t*)p)); }

__device__ __forceinline__ void ld_bf16(v4u (&R)[8], rsrc_t rs, int soff, int lane) {
    const int voff = ((lane >> 4) * DH + (lane & 15) * 8) * 2;
#pragma unroll
    for (int i = 0; i < 8; ++i) R[i] = __builtin_bit_cast(v4u, __builtin_amdgcn_raw_buffer_load_b128(rs, voff, soff + i * (4 * DH * 2), 0));
}
__device__ __forceinline__ void st_k_bf16(LAS char* img, const v4u (&R)[8], int lane) {
    LAS char* p = img + (lane >> 4) * KST + (lane & 15) * 16;
#pragma unroll
    for (int i = 0; i < 8; ++i) *(LAS v4u*)(p + i * 4 * KST) = R[i];
}
__device__ __forceinline__ void st_v_bf16(LAS char* img, const v4u (&R)[8], int lane) {
    LAS char* p = img + (lane >> 4) * VST + (lane & 15) * 16;
#pragma unroll
    for (int i = 0; i < 8; ++i) *(LAS v4u*)(p + i * 4 * VST) = R[i];
}
__device__ __forceinline__ void ld_f32(f32x4 (&R)[16], rsrc_t rs, int soff, int lane) {
    const int voff = ((lane >> 5) * DH + (lane & 31) * 4) * 4;
#pragma unroll
    for (int i = 0; i < 16; ++i) R[i] = __builtin_bit_cast(f32x4, __builtin_amdgcn_raw_buffer_load_b128(rs, voff, soff + i * (2 * DH * 4), 0));
}
__device__ __forceinline__ void st_k_f32(LAS char* img, const f32x4 (&R)[16], int lane) {
    LAS char* p = img + (lane >> 5) * KST + (lane & 31) * 8;
#pragma unroll
    for (int i = 0; i < 16; ++i) { v2u w; w.x = cvtpk(R[i].x, R[i].y); w.y = cvtpk(R[i].z, R[i].w); *(LAS v2u*)(p + i * 2 * KST) = w; }
}
__device__ __forceinline__ void st_v_f32(LAS char* img, const f32x4 (&R)[16], int lane) {
    LAS char* p = img + (lane >> 5) * VST + (lane & 31) * 8;
#pragma unroll
    for (int i = 0; i < 16; ++i) { v2u w; w.x = cvtpk(R[i].x, R[i].y); w.y = cvtpk(R[i].z, R[i].w); *(LAS v2u*)(p + i * 2 * VST) = w; }
}
template <bool MASK>
__device__ __forceinline__ void s_part(LAS const char* img, LAS const char* Qimg, float& run, bf16x8& wf0, bf16x8& wf1, int r32, int hi) {
    f32x16 st;
#pragma unroll
    for (int i = 0; i < 16; ++i) st[i] = 0.f;
    const int fo = r32 * KST + hi * 16;
#pragma unroll
    for (int s = 0; s < 8; ++s) { const bf16x8 kf = *(LAS const bf16x8*)(img + fo + 32 * s), qf = *(LAS const bf16x8*)(Qimg + fo + 32 * s); st = __builtin_amdgcn_mfma_f32_32x32x16_bf16(kf, qf, st, 0, 0, 0); }
    float lb[16], ex[16], T[4];
#pragma unroll
    for (int i = 0; i < 16; ++i) { const float z = st[i]; const float e = __builtin_amdgcn_exp2f(-__builtin_fabsf(z)); const float lp = __builtin_amdgcn_logf(1.0f + e);
        float a = __builtin_fminf(z, 0.f) - lp, l1 = __builtin_fminf(-z, 0.f) - lp;
        if (MASK) { if (crow(i, hi) >= r32) { a = -INFINITY; l1 = 0.f; } }
        lb[i] = a; ex[i] = l1; }
#pragma unroll
    for (int g = 0; g < 4; ++g) { const float l0 = ex[4 * g], l1 = ex[4 * g + 1], l2 = ex[4 * g + 2], l3 = ex[4 * g + 3];
        ex[4 * g + 3] = 0.f; ex[4 * g + 2] = l3; ex[4 * g + 1] = l3 + l2; ex[4 * g] = (l3 + l2) + l1; T[g] = ((l3 + l2) + l1) + l0; }
    float P[4], U[4];
#pragma unroll
    for (int g = 0; g < 4; ++g) { P[g] = __shfl_xor(T[g], 32); U[g] = T[g] + P[g]; }
    const float A2 = U[3], A1 = U[3] + U[2], A0 = A1 + U[1], tot = A0 + U[0];
    float off[4]; off[3] = run; off[2] = run + A2; off[1] = run + A1; off[0] = run + A0;
    if (hi == 0) {
#pragma unroll
        for (int g = 0; g < 4; ++g) off[g] += P[g]; }
    float w[16];
#pragma unroll
    for (int i = 0; i < 16; ++i) w[i] = __builtin_amdgcn_exp2f(lb[i] + (off[i >> 2] + ex[i]));
    run += tot;
    v4u a, b; a.x = cvtpk(w[0], w[1]); a.y = cvtpk(w[2], w[3]); a.z = cvtpk(w[4], w[5]); a.w = cvtpk(w[6], w[7]);
    b.x = cvtpk(w[8], w[9]); b.y = cvtpk(w[10], w[11]); b.z = cvtpk(w[12], w[13]); b.w = cvtpk(w[14], w[15]);
    wf0 = __builtin_bit_cast(bf16x8, a); wf1 = __builtin_bit_cast(bf16x8, b);
}
__device__ __forceinline__ void pv_part(LAS const char* img, f32x16 (&o)[4], const bf16x8 wf0, const bf16x8 wf1, int lane) {
    const int i = lane & 15, q4 = i >> 2, p = i & 3, hi = lane >> 5;
    LAS const char* vb = img + (4 * hi + q4) * VST + 32 * ((lane >> 4) & 1) + 8 * p;
#pragma unroll
    for (int dblk = 0; dblk < 4; ++dblk)
#pragma unroll
        for (int s = 0; s < 2; ++s) {
            const s16x4 lo = vtr(vb + 16 * s * VST + 64 * dblk), hh = vtr(vb + (16 * s + 8) * VST + 64 * dblk);
            const bf16x8 vf = (bf16x8){lo[0], lo[1], lo[2], lo[3], hh[0], hh[1], hh[2], hh[3]};
            o[dblk] = __builtin_amdgcn_mfma_f32_32x32x16_bf16(vf, s ? wf1 : wf0, o[dblk], 0, 0, 0); }
}
template <bool MASK>
__device__ __forceinline__ void tile_bf16(v4u (&R)[8], rsrc_t rk, rsrc_t rv, int vo, int kno, f32x16 (&o)[4], float& run, LAS char* img, LAS char* Qimg, int lane) {
    st_k_bf16(img, R, lane);
    ld_bf16(R, rv, vo, lane);
    CFENCE();
    bf16x8 wf0, wf1;
    s_part<MASK>(img, Qimg, run, wf0, wf1, lane & 31, lane >> 5);
    CFENCE();
    st_v_bf16(img, R, lane);
    ld_bf16(R, rk, kno, lane);
    CFENCE();
    pv_part(img, o, wf0, wf1, lane);
    CFENCE();
}
template <bool EARLY>
__device__ __forceinline__ void range_bf16(rsrc_t rk, rsrc_t rv, int off0, int tau_hi, int tau_lo, bool first_masked, f32x16 (&o)[4], float& run, LAS char* img, LAS char* Qimg, int lane) {
    if (tau_hi < tau_lo) return;
    constexpr int TB = 32 * DH * 2;
    v4u R[8];
    ld_bf16(R, rk, off0 + tau_hi * TB, lane);
    int tau = tau_hi;
    if (first_masked) { tile_bf16<true>(R, rk, rv, off0 + tau * TB, off0 + (tau > tau_lo ? tau - 1 : tau) * TB, o, run, img, Qimg, lane); --tau; }
    for (; tau >= tau_lo; --tau) {
        tile_bf16<false>(R, rk, rv, off0 + tau * TB, off0 + (tau > tau_lo ? tau - 1 : tau) * TB, o, run, img, Qimg, lane);
        if (EARLY) { if (__all(run < EXIT_THR)) break; }
    }
}
__device__ __forceinline__ void tile_f32(f32x4 (&R)[16], rsrc_t rk, rsrc_t rv, int vo, int kno, f32x16 (&o)[4], float& run, LAS char* img, LAS char* Qimg, int lane) {
    st_k_f32(img, R, lane);
    ld_f32(R, rv, vo, lane);
    CFENCE();
    bf16x8 wf0, wf1;
    s_part<false>(img, Qimg, run, wf0, wf1, lane & 31, lane >> 5);
    CFENCE();
    st_v_f32(img, R, lane);
    ld_f32(R, rk, kno, lane);
    CFENCE();
    pv_part(img, o, wf0, wf1, lane);
    CFENCE();
}
template <bool EARLY>
__device__ __forceinline__ void range_f32(rsrc_t rk, rsrc_t rv, int off0, int tau_hi, int tau_lo, f32x16 (&o)[4], float& run, LAS char* img, LAS char* Qimg, int lane) {
    if (tau_hi < tau_lo) return;
    constexpr int TB = 32 * DH * 4;
    f32x4 R[16];
    ld_f32(R, rk, off0 + tau_hi * TB, lane);
    for (int tau = tau_hi; tau >= tau_lo; --tau) {
        tile_f32(R, rk, rv, off0 + tau * TB, off0 + (tau > tau_lo ? tau - 1 : tau) * TB, o, run, img, Qimg, lane);
        if (EARLY) { if (__all(run < EXIT_THR)) break; }
    }
}
__device__ __forceinline__ void load_q(LAS char* Qimg, rsrc_t rq, int soff  , int lane) {
    v4u R[8]; ld_bf16(R, rq, soff, lane); st_k_bf16(Qimg, R, lane); CFENCE();
}
__device__ __forceinline__ void zero_o(f32x16 (&o)[4]) {
#pragma unroll
    for (int d = 0; d < 4; ++d)
#pragma unroll
        for (int i = 0; i < 16; ++i) o[d][i] = 0.f;
}
__device__ __forceinline__ void epi_store(const f32x16 (&o)[4], const bf16* Gs_row, bf16* MIX_row, int hi) {
#pragma unroll
    for (int dblk = 0; dblk < 4; ++dblk)
#pragma unroll
        for (int g = 0; g < 4; ++g) { const int d0 = 32 * dblk + 8 * g + 4 * hi; const v2u gg = *(const GAS v2u*)(Gs_row + d0);
            v2u w; w.x = cvtpk(o[dblk][4 * g] * bflo(gg.x), o[dblk][4 * g + 1] * bfhi(gg.x)); w.y = cvtpk(o[dblk][4 * g + 2] * bflo(gg.y), o[dblk][4 * g + 3] * bfhi(gg.y));
            *(GAS v2u*)(MIX_row + d0) = w; }
}
struct Ctx { const bf16 *Qb, *Kb, *Vb, *Gs; bf16* MIX; const float *ck, *cv; };

template <bool EARLY>
__device__ __forceinline__ void attn_phase(LAS unsigned char* lds, const Ctx& C, int vcu, int G, int wave, int lane) {
    LAS char* region = (LAS char*)lds + wave * ATT_REGION; LAS char* img = region; LAS char* Qimg = region + QIMG_OFF;
    LAS float* xch = (LAS float*)((LAS char*)lds + XCH_OFF);
    const int r32 = lane & 31, hi = lane >> 5;
    const rsrc_t rQ = mk_rsrc(C.Qb, (unsigned)MT * DH * 2), rK = mk_rsrc(C.Kb, (unsigned)MT * DH * 2), rV = mk_rsrc(C.Vb, (unsigned)MT * DH * 2);
    const rsrc_t rCK = mk_rsrc(C.ck, (unsigned)DB * PAST * DH * 4), rCV = mk_rsrc(C.cv, (unsigned)DB * PAST * DH * 4);
    for (int unit = vcu; unit < 256; unit += G) {
        {
            const int b = unit >> 3, h = unit & 7; const size_t qrow = (size_t)MP + 32 * b + r32;
            const int new0 = ((MP + 32 * b) * DH + h * HD) * 2;
            const int c0 = (b * PAST * DH + h * HD) * 4;
            load_q(Qimg, rQ, new0, lane);
            f32x16 o[4]; zero_o(o); float run = 0.f;
            if (wave == 7) {
                range_bf16<false>(rK, rV, new0, 0, 0, true, o, run, img, Qimg, lane);
                range_f32<EARLY>(rCK, rCV, c0, 31, 28, o, run, img, Qimg, lane);
            } else range_f32<EARLY>(rCK, rCV, c0, 4 * wave + 3, 4 * wave, o, run, img, Qimg, lane);
            if (hi == 0) xch[wave * 32 + r32] = run;
            __syncthreads();
            float fs = 0.f;
            for (int w2 = wave + 1; w2 < 8; ++w2) fs += xch[w2 * 32 + r32];
            const float f = __builtin_amdgcn_exp2f(fs);
            LAS float* rg = (LAS float*)region;
#pragma unroll
            for (int d = 0; d < 4; ++d)
#pragma unroll
                for (int i = 0; i < 16; ++i) rg[(d * 16 + i) * 64 + lane] = o[d][i] * f;
            __syncthreads();
            float res[8];
#pragma unroll
            for (int j = 0; j < 8; ++j) { float s = 0.f;
#pragma unroll
                for (int w2 = 0; w2 < 8; ++w2) s += ((LAS const float*)((LAS const char*)lds + w2 * ATT_REGION))[(8 * wave + j) * 64 + lane];
                res[j] = s; }
            const bf16* Gs_row = C.Gs + qrow * DH + h * HD; bf16* MIX_row = C.MIX + qrow * DM + h * HD;
#pragma unroll
            for (int jj = 0; jj < 2; ++jj) { const int d0 = 32 * (wave >> 1) + 8 * (2 * (wave & 1) + jj) + 4 * hi; const v2u gg = *(const GAS v2u*)(Gs_row + d0);
                v2u w; w.x = cvtpk(res[4 * jj] * bflo(gg.x), res[4 * jj + 1] * bfhi(gg.x)); w.y = cvtpk(res[4 * jj + 2] * bflo(gg.y), res[4 * jj + 3] * bfhi(gg.y));
                *(GAS v2u*)(MIX_row + d0) = w; }
            __syncthreads();
        }
        {
            const int bh = unit >> 3, b = bh >> 3, h = bh & 7, i = 4 * (unit & 7) + (wave & 3);
            const int s0 = (b * SEQ * DH + h * HD) * 2;
            constexpr int TB = 32 * DH * 2;
            f32x16 o[4]; float run;
            const int qt2 = 63 - i; const size_t qrow2 = (size_t)b * SEQ + 32 * qt2 + r32;
            if (wave < 4) {
                const size_t qrow1 = (size_t)b * SEQ + 32 * i + r32;
                load_q(Qimg, rQ, s0 + i * TB, lane); zero_o(o); run = 0.f;
                range_bf16<EARLY>(rK, rV, s0, i, 0, true, o, run, img, Qimg, lane);
                epi_store(o, C.Gs + qrow1 * DH + h * HD, C.MIX + qrow1 * DM + h * HD, hi);
                load_q(Qimg, rQ, s0 + qt2 * TB, lane); zero_o(o); run = 0.f;
                range_bf16<EARLY>(rK, rV, s0, 31 - i, 0, false, o, run, img, Qimg, lane);
            } else {
                load_q(Qimg, rQ, s0 + qt2 * TB, lane); zero_o(o); run = 0.f;
                range_bf16<EARLY>(rK, rV, s0, qt2, 32 - i, true, o, run, img, Qimg, lane);
                if (hi == 0) xch[wave * 32 + r32] = run;
            }
            __syncthreads();
            LAS float* rg = (LAS float*)((LAS char*)lds + (wave & 3) * ATT_REGION);
            if (wave < 4) {
                const float f = __builtin_amdgcn_exp2f(xch[(wave + 4) * 32 + r32]);
#pragma unroll
                for (int d = 0; d < 4; ++d)
#pragma unroll
                    for (int k = 0; k < 16; ++k) rg[(d * 16 + k) * 64 + lane] = o[d][k] * f;
            }
            __syncthreads();
            if (wave >= 4) {
#pragma unroll
                for (int d = 0; d < 4; ++d)
#pragma unroll
                    for (int k = 0; k < 16; ++k) o[d][k] += rg[(d * 16 + k) * 64 + lane];
                epi_store(o, C.Gs + qrow2 * DH + h * HD, C.MIX + qrow2 * DM + h * HD, hi);
            }
            __syncthreads();
        }
    }
}
}

struct Args { const float* in[10]; float* out; unsigned char* ws; int ph_mask; int pad; };
#ifndef SB_EARLY
#define SB_EARLY false
#endif
__global__ void __launch_bounds__(NWAVES * 64, 2) mk_fwd(Args args) {
    extern __shared__ __attribute__((aligned(16))) unsigned char lds[];
    Frame F;
    F.lds = (LAS unsigned char*)lds;
    F.MISC = (volatile LAS unsigned*)(F.lds + MISC_OFF);
    F.tid = threadIdx.x; F.lane = F.tid & 63; F.wave = __builtin_amdgcn_readfirstlane(F.tid >> 6);
    F.G = gridDim.x; { const int bx = blockIdx.x; F.vcu = (F.G % 8 == 0) ? (bx % 8) * (F.G / 8) + bx / 8 : bx; }
    unsigned char* ws = args.ws;
    F.ctl = (gu32*)(ws + WS_CTL);
    F.xp = args.in[0]; F.xs = args.in[1]; F.ck = args.in[2]; F.cv = args.in[3]; F.sconv = args.in[4]; F.norm_g = args.in[5]; F.w_in = args.in[6]; F.conv_w = args.in[7]; F.w_out = args.in[8]; F.final_g = args.in[9];
    F.out = args.out;
    F.Win_t = (bf16*)(ws + WS_WIN); F.Wout_t = (bf16*)(ws + WS_WOUT); F.H = (bf16*)(ws + WS_H); F.Qb = (bf16*)(ws + WS_Q); F.Kb = (bf16*)(ws + WS_K); F.Vb = (bf16*)(ws + WS_V);
    F.Gs = (bf16*)(ws + WS_GS); F.CU = (bf16*)(ws + WS_CU); F.BG = (bf16*)(ws + WS_BG); F.MIX = (bf16*)(ws + WS_MIX);
    for (int u = F.tid; u < (LDS_BYTES - LDSCTL_OFF) / 4; u += NWAVES * 64) ((LAS unsigned*)(F.lds + LDSCTL_OFF))[u] = 0u;
    __syncthreads();
    const int pm = args.ph_mask;
    const bool multi = (pm & (pm - 1)) != 0 && pm != 12;
    XcdBarrier bar; bar.bar = (unsigned*)(F.ctl + 4096); bar.x = 0; bar.st = nullptr;
    if (multi) bar = xcd_barrier_post((unsigned*)(F.ctl + 4096), F.MISC + 8);
#define SEAM(rest) do { if (multi && (pm & (rest))) xcd_barrier(bar); } while (0)

    if (pm & 1) { p0_prologue(F); SEAM(62); }
    if (pm & 2) {
        pg8::Gemm g{F.H, F.Win_t, MT, DIN, DM}; pg8::StaticOrder S; S.init(MT, DIN, F.G, (int)blockIdx.x);
        pg8::Epi1 E{F.Qb, F.Kb, F.Vb, F.Gs, F.CU, F.BG, F.out};
        pg8::gemm_phase<pg8::Epi1, pg8::StaticOrder, true, true>(F.lds + RING_OFF, g, S, E);
        SEAM(60);
    }
    if (pm & 4) { const sb::Ctx C{F.Qb, F.Kb, F.Vb, F.Gs, F.MIX, F.ck, F.cv}; sb::attn_phase<SB_EARLY>(F.lds, C, F.vcu, F.G, F.wave, F.lane); }
    if (pm & 8) { p2_convmix(F); }
    if (pm & 12) { SEAM(48); }
    if (pm & 16) {
        pg8::Gemm g{F.MIX, F.Wout_t, MT, DM, DM}; pg8::StaticOrder S; S.init(MT, DM, F.G, (int)blockIdx.x);
        pg8::Epi2 E{F.xp, F.xs, F.out + O_Y};
        pg8::gemm_phase<pg8::Epi2, pg8::StaticOrder, true, true>(F.lds + RING_OFF, g, S, E);
        SEAM(32);
    }
    if (pm & 32) { p4_final_norm(F); }
#undef SEAM
}

#ifndef NAIVE_P1
#define NAIVE_P1 0
#endif
#ifndef NAIVE_P2
#define NAIVE_P2 0
#endif
#ifndef NAIVE_P3
#define NAIVE_P3 0
#endif
#ifndef ONE_LAUNCH
#define ONE_LAUNCH 1
#endif
#if NAIVE_P1 || NAIVE_P3
__global__ void __launch_bounds__(256) gemm_naive(const bf16* A, const bf16* Bt, float* C, int M, int N, int K) {
    __shared__ float As[32][65], Bs[32][65];
    const int t = threadIdx.x, tx = t & 15, ty = t >> 4, m0 = blockIdx.y * 64, n0 = blockIdx.x * 64;
    float acc[4][4];
#pragma unroll
    for (int i = 0; i < 4; ++i)
#pragma unroll
        for (int j = 0; j < 4; ++j) acc[i][j] = 0.f;
    for (int k0 = 0; k0 < K; k0 += 32) {
        { const v4u a = *(const v4u*)(A + (size_t)(m0 + (t >> 2)) * K + k0 + (t & 3) * 8); float f[8]; unpack8(a, f);
#pragma unroll
          for (int j = 0; j < 8; ++j) As[(t & 3) * 8 + j][t >> 2] = f[j]; }
        { const v4u a = *(const v4u*)(Bt + (size_t)(n0 + (t >> 2)) * K + k0 + (t & 3) * 8); float f[8]; unpack8(a, f);
#pragma unroll
          for (int j = 0; j < 8; ++j) Bs[(t & 3) * 8 + j][t >> 2] = f[j]; }
        __syncthreads();
#pragma unroll 8
        for (int kk = 0; kk < 32; ++kk) { float a[4], b[4];
#pragma unroll
            for (int i = 0; i < 4; ++i) { a[i] = As[kk][ty * 4 + i]; b[i] = Bs[kk][tx * 4 + i]; }
#pragma unroll
            for (int i = 0; i < 4; ++i)
#pragma unroll
                for (int j = 0; j < 4; ++j) acc[i][j] += a[i] * b[j]; }
        __syncthreads();
    }
#pragma unroll
    for (int i = 0; i < 4; ++i)
#pragma unroll
        for (int j = 0; j < 4; ++j) C[(size_t)(m0 + ty * 4 + i) * N + n0 + tx * 4 + j] = acc[i][j];
}
#endif
#if NAIVE_P1
__device__ __forceinline__ unsigned short f2bf1(float f) { return (unsigned short)(cvtpk(f, 0.f) & 0xffffu); }
__global__ void __launch_bounds__(256) epi1_naive(const float* C, bf16* Qb, bf16* Kb, bf16* Vb, bf16* Gs, bf16* CU, bf16* BG, float* out) {
    const size_t gid = (size_t)blockIdx.x * 256 + threadIdx.x; if (gid >= (size_t)MT * 32 * 128) return;
    const int cc = (int)(gid & 127), pn = (int)((gid >> 7) & 31), row = (int)(gid >> 12);
    const float v0 = C[(size_t)row * DIN + 256 * pn + cc], v1 = C[(size_t)row * DIN + 256 * pn + 128 + cc];
    if (pn < 16) {
        const int typ = pn >> 2;
        for (int k = 0; k < 2; ++k) { const int col = (pn & 3) * 256 + cc + 128 * k; float v = k ? v1 : v0;
            if (typ == 0) Qb[(size_t)row * DH + col] = f2bf1(v * C2);
            else if (typ == 3) Gs[(size_t)row * DH + col] = f2bf1(v / (1.f + expf(-v)));
            else { (typ == 1 ? Kb : Vb)[(size_t)row * DH + col] = f2bf1(v);
                   out[(row < MP ? (typ == 1 ? O_KP : O_VP) + (size_t)row * DH : (typ == 1 ? O_KS : O_VS) + (size_t)(row - MP) * DH) + col] = v; } }
    } else if (pn < 24) {
        const int ch = (pn - 16) * 128 + cc; const float cu = v0 * v1; CU[(size_t)row * DH + ch] = f2bf1(cu);
        if (row < MP) { const int t = row & (SEQ - 1); if (t >= SEQ - 2) out[O_CP + (size_t)((row >> 11) * 2 + (t - (SEQ - 2))) * DH + ch] = cu; }
        else { const int r2 = row - MP, t = r2 & (DS - 1); if (t >= DS - 2) out[O_CS + (size_t)((r2 >> 5) * 2 + (t - (DS - 2))) * DH + ch] = cu; }
    } else { const int ch = (pn - 24) * 128 + cc; BG[(size_t)row * DH + ch] = f2bf1(v0 * (v1 / (1.f + expf(-v1)))); }
}
#endif
#if NAIVE_P3
__global__ void __launch_bounds__(256) epi2_naive(const float* C, const float* xp, const float* xs, float* y) {
    const size_t gid = (size_t)blockIdx.x * 256 + threadIdx.x; if (gid >= (size_t)MT * DM) return;
    const size_t row = gid / DM, col = gid % DM; const float x = row < MP ? xp[row * DM + col] : xs[(row - MP) * DM + col];
    y[gid] = x + C[gid];
}
#endif
#if NAIVE_P2
__global__ void __launch_bounds__(256) attn_naive(const bf16* Qb, const bf16* Kb, const bf16* Vb, const bf16* Gs, const float* ck, const float* cv, bf16* MIX) {
    const int gw = blockIdx.x * 4 + (threadIdx.x >> 6), lane = threadIdx.x & 63; if (gw >= MT * NH) return;
    const int row = gw >> 3, h = gw & 7, d = 2 * lane;
    const float q0 = bf2f(Qb[(size_t)row * DH + h * HD + d]), q1 = bf2f(Qb[(size_t)row * DH + h * HD + d + 1]);
    float run = 0.f, o0 = 0.f, o1 = 0.f;
    int nnew, krow0, ncache = 0, b;
    if (row < MP) { b = row >> 11; nnew = row & (SEQ - 1); krow0 = b * SEQ; } else { const int r2 = row - MP; b = r2 >> 5; nnew = r2 & (DS - 1); krow0 = MP + b * DS; ncache = PAST; }
    for (int j = nnew - 1; j >= 0; --j) {
        const size_t kr = (size_t)(krow0 + j) * DH + h * HD + d;
        float p = q0 * bf2f(Kb[kr]) + q1 * bf2f(Kb[kr + 1]);
#pragma unroll
        for (int s = 1; s < 64; s <<= 1) p += __shfl_xor(p, s);
        const float z = p, e = exp2f(-fabsf(z)), lp = log2f(1.f + e), lb = fminf(z, 0.f) - lp, l1 = fminf(-z, 0.f) - lp, w = exp2f(lb + run);
        o0 += w * bf2f(Vb[kr]); o1 += w * bf2f(Vb[kr + 1]); run += l1;
    }
    for (int j = ncache - 1; j >= 0; --j) {
        const size_t kr = ((size_t)b * PAST + j) * DH + h * HD + d;
        float p = q0 * ck[kr] + q1 * ck[kr + 1];
#pragma unroll
        for (int s = 1; s < 64; s <<= 1) p += __shfl_xor(p, s);
        const float z = p, e = exp2f(-fabsf(z)), lp = log2f(1.f + e), lb = fminf(z, 0.f) - lp, l1 = fminf(-z, 0.f) - lp, w = exp2f(lb + run);
        o0 += w * cv[kr]; o1 += w * cv[kr + 1]; run += l1;
    }
    const size_t gi = (size_t)row * DH + h * HD + d;
    const unsigned w = cvtpk(o0 * bf2f(Gs[gi]), o1 * bf2f(Gs[gi + 1]));
    *(unsigned*)(MIX + (size_t)row * DM + h * HD + d) = w;
}
#endif

extern "C" void kernel_launch(void* const* d_in, const int* in_sizes, int n_in, void* d_out, int out_size, void* d_ws, size_t ws_size, hipStream_t stream) {
    static int grid = 0;
    if (grid == 0) {
        if (n_in != 10 || (size_t)out_size != O_END || ws_size < 512 * MiB) { fprintf(stderr, "kernel_launch: unexpected sizes: n_in %d out %d ws %zu; nothing launched\n", n_in, out_size, ws_size); grid = -1; return; }
        int dev = 0, cus = 0, per_cu = 0;
        if (hipGetDevice(&dev) != hipSuccess || hipDeviceGetAttribute(&cus, hipDeviceAttributeMultiprocessorCount, dev) != hipSuccess) { grid = -1; return; }
        if (hipFuncSetAttribute((const void*)mk_fwd, hipFuncAttributeMaxDynamicSharedMemorySize, LDS_BYTES) != hipSuccess) { fprintf(stderr, "kernel_launch: hipFuncSetAttribute failed\n"); grid = -1; return; }
        if (hipOccupancyMaxActiveBlocksPerMultiprocessor(&per_cu, (const void*)mk_fwd, NWAVES * 64, LDS_BYTES) != hipSuccess || per_cu < 1) { fprintf(stderr, "kernel_launch: occupancy query says %d blocks per CU\n", per_cu); grid = -1; (void)hipGetLastError(); return; }
        grid = cus;
    }
    if (grid < 0) return;
    (void)hipMemsetAsync((char*)d_ws + WS_CTL, 0, CTL_ZERO_BYTES, stream);
    Args a{};
    for (int i = 0; i < 10; ++i) a.in[i] = (const float*)d_in[i];
    a.out = (float*)d_out; a.ws = (unsigned char*)d_ws;
    unsigned char* ws = (unsigned char*)d_ws;
#if ONE_LAUNCH
    a.ph_mask = 63;
    void* kargs[] = {&a};
    hipError_t e = hipLaunchCooperativeKernel((const void*)mk_fwd, dim3(grid), dim3(NWAVES * 64), kargs, LDS_BYTES, stream);
    if (e != hipSuccess) fprintf(stderr, "kernel_launch: cooperative launch failed: %s (grid %d)\n", hipGetErrorString(e), grid);
#else
#define LAUNCH_PH(mask) do { a.ph_mask = (mask); hipLaunchKernelGGL(mk_fwd, dim3(grid), dim3(NWAVES * 64), LDS_BYTES, stream, a); } while (0)
    LAUNCH_PH(1);
#if NAIVE_P1
    gemm_naive<<<dim3(DIN / 64, MT / 64), 256, 0, stream>>>((const bf16*)(ws + WS_H), (const bf16*)(ws + WS_WIN), (float*)(ws + WS_TMP), MT, DIN, DM);
    epi1_naive<<<(unsigned)(((size_t)MT * 32 * 128 + 255) / 256), 256, 0, stream>>>((const float*)(ws + WS_TMP), (bf16*)(ws + WS_Q), (bf16*)(ws + WS_K), (bf16*)(ws + WS_V), (bf16*)(ws + WS_GS), (bf16*)(ws + WS_CU), (bf16*)(ws + WS_BG), (float*)d_out);
#else
    LAUNCH_PH(2);
#endif
#if NAIVE_P2
    attn_naive<<<MT * NH / 4, 256, 0, stream>>>((const bf16*)(ws + WS_Q), (const bf16*)(ws + WS_K), (const bf16*)(ws + WS_V), (const bf16*)(ws + WS_GS), (const float*)d_in[2], (const float*)d_in[3], (bf16*)(ws + WS_MIX));
    LAUNCH_PH(8);
#else
    LAUNCH_PH(12);
#endif
#if NAIVE_P3
    gemm_naive<<<dim3(DM / 64, MT / 64), 256, 0, stream>>>((const bf16*)(ws + WS_MIX), (const bf16*)(ws + WS_WOUT), (float*)(ws + WS_TMP), MT, DM, DM);
    epi2_naive<<<(unsigned)(((size_t)MT * DM + 255) / 256), 256, 0, stream>>>((const float*)(ws + WS_TMP), (const float*)d_in[0], (const float*)d_in[1], (float*)d_out + O_Y);
#else
    LAUNCH_PH(16);
#endif
    LAUNCH_PH(32);
#endif
    (void)ws;
}
```

```cpp
#include <hip/hip_runtime.h>
#include <cstdio>
#include <cstdint>

constexpr int DM = 2048;
constexpr int NB = 4, SEQ = 2048;
constexpr int DB = 32, DS = 32, PAST = 1024;
constexpr int MP = NB * SEQ;
constexpr int MS = DB * DS;
constexpr int MT = MP + MS;
constexpr int DIN = 8192;
constexpr int DH = 1024;
constexpr int NH = 8, HD = 128;
constexpr float EPS = 1e-6f;
constexpr float C2 = 0.08838834764831845f * 1.4426950408889634f;

constexpr size_t O_Y = 0;
constexpr size_t O_KP = (size_t)MT * DM;
constexpr size_t O_VP = O_KP + (size_t)MP * DH;
constexpr size_t O_CP = O_VP + (size_t)MP * DH;
constexpr size_t O_KS = O_CP + (size_t)NB * 2 * DH;
constexpr size_t O_VS = O_KS + (size_t)MS * DH;
constexpr size_t O_CS = O_VS + (size_t)MS * DH;
constexpr size_t O_END = O_CS + (size_t)DB * 2 * DH;

constexpr size_t MiB = 1u << 20;
constexpr size_t WS_CTL = 0, CTL_ZERO_BYTES = 1 * MiB;
constexpr size_t WS_WIN = 2 * MiB;
constexpr size_t WS_WOUT = 34 * MiB;
constexpr size_t WS_H = 42 * MiB;
constexpr size_t WS_Q = 78 * MiB, WS_K = 96 * MiB, WS_V = 114 * MiB, WS_GS = 132 * MiB, WS_CU = 150 * MiB, WS_BG = 168 * MiB;
constexpr size_t WS_MIX = 186 * MiB;
constexpr size_t WS_TMP = 224 * MiB;
constexpr size_t WS_END = 222 * MiB;

typedef unsigned short bf16;
#define GAS __attribute__((address_space(1)))
#define LAS __attribute__((address_space(3)))
#define NAIVE_P1 0
#define NAIVE_P2 0
#define NAIVE_P3 0
#define ONE_LAUNCH 1
namespace pg8 {
#define PG8_LAS __attribute__((address_space(3)))
typedef unsigned short bf16_t;
typedef short bf16x8 __attribute__((ext_vector_type(8)));
typedef float f32x4 __attribute__((ext_vector_type(4)));
typedef unsigned u32x4 __attribute__((ext_vector_type(4)));
constexpr int BM = 256, BK = 64, HALF = 128, HTB = HALF * BK * 2  , STAGE_BYTES = 8 * HTB, NXCD = 8, WGM = 8;

__host__ __device__ __forceinline__ int lds_byte(int r, int c) { const int st = (r >> 4) * 2 + (c >> 5), rr = r & 15, cc = c & 31, ob = rr * 64 + cc * 2; return st * 1024 + (ob ^ (((ob >> 9) & 1) << 5)); }
__host__ __device__ __forceinline__ void stage_rc(int b, int& R, int& C) { const int st = b / 1024, sb = b % 1024, swz = sb ^ (((sb >> 9) & 1) << 5); R = (st >> 1) * 16 + swz / 64; C = (st & 1) * 32 + (swz % 64) / 2; }
__host__ __device__ __forceinline__ int perm32(int rho) { const int n = rho >> 4, i = rho & 15; return 8 * (i >> 2) + 4 * n + (i & 3); }

struct Unit { int pm, pn; };
struct Gemm { const bf16_t* A; const bf16_t* Bt; int M, N, K; };

struct StaticOrder {
    int nM, nN, nwg, G, c;
    __host__ __device__ void init(int M, int N, int G_, int c_) { nM = M / BM; nN = N / BM; nwg = nM * nN; G = G_; c = c_; }
    __host__ __device__ bool next(int i, Unit& u) const {
        const long L = (long)i * G + c; if (L >= nwg) return false;
        int wgid = (int)L; { const int q = nwg / NXCD, r = nwg % NXCD, xcd = wgid % NXCD, off = wgid / NXCD; wgid = (xcd < r ? xcd * (q + 1) : r * (q + 1) + (xcd - r) * q) + off; }
        const int nig = WGM * nN, gid = wgid / nig, fm = gid * WGM, gsz = (nM - fm) < WGM ? (nM - fm) : WGM;
        u.pm = fm + ((wgid % nig) % gsz); u.pn = (wgid % nig) / gsz; return true;
    }
    __device__ __forceinline__ void a_ready(const Unit&) const {}
    __device__ __forceinline__ void done(const Unit&) const {}
};

typedef float f32x2_t __attribute__((ext_vector_type(2))); typedef __bf16 bf16x2_t __attribute__((ext_vector_type(2)));
__device__ __forceinline__ unsigned cvtpk(float lo, float hi) { f32x2_t v = {lo, hi}; bf16x2_t b = __builtin_convertvector(v, bf16x2_t); return __builtin_bit_cast(unsigned, b); }
__device__ __forceinline__ float silu_f(float x) { return x * __builtin_amdgcn_rcpf(1.0f + __builtin_amdgcn_exp2f(-1.4426950408889634f * x)); }
__device__ __forceinline__ f32x4 silu4(f32x4 v) { f32x4 o; o[0] = silu_f(v[0]); o[1] = silu_f(v[1]); o[2] = silu_f(v[2]); o[3] = silu_f(v[3]); return o; }

struct Epi1 {
    static constexpr bool PERM = true, AFTER_DRAIN = false;
    bf16_t *Qb, *Kb, *Vb, *Gs, *CU, *BG; float* out;
    __device__ __forceinline__ void operator()(const f32x4 (&acc)[2][2][4][2], const Unit& u, int wr, int wc, int fr, int fq) const {
        const int pn = u.pn, row0 = u.pm * BM + wr * 64 + fr, cl = wc * 32 + 8 * fq;
        if (pn < 16) {
            const int typ = pn >> 2, colb = (pn & 3) * 256 + cl;
            bf16_t* dst = typ == 0 ? Qb : (typ == 1 ? Kb : (typ == 2 ? Vb : Gs));
#pragma unroll
            for (int ai = 0; ai < 2; ++ai)
#pragma unroll
                for (int m = 0; m < 4; ++m) { const int row = row0 + ai * HALF + m * 16;
#pragma unroll
                    for (int bj = 0; bj < 2; ++bj) { const int col = colb + bj * HALF; f32x4 v0 = acc[ai][bj][m][0], v1 = acc[ai][bj][m][1];
                        if (typ == 0) { v0 = v0 * C2; v1 = v1 * C2; }
                        if (typ == 3) { v0 = silu4(v0); v1 = silu4(v1); }
                        if (typ == 1 || typ == 2) {
                            float* o = out + (row < MP ? (typ == 1 ? O_KP : O_VP) + (size_t)row * DH : (typ == 1 ? O_KS : O_VS) + (size_t)(row - MP) * DH) + col;
                            *(f32x4*)o = v0; *(f32x4*)(o + 4) = v1; }
                        u32x4 w; w.x = cvtpk(v0[0], v0[1]); w.y = cvtpk(v0[2], v0[3]); w.z = cvtpk(v1[0], v1[1]); w.w = cvtpk(v1[2], v1[3]);
                        *(u32x4*)(dst + (size_t)row * DH + col) = w; } }
        } else if (pn < 24) {
            const int chb = (pn - 16) * 128 + cl;
#pragma unroll
            for (int ai = 0; ai < 2; ++ai)
#pragma unroll
                for (int m = 0; m < 4; ++m) { const int row = row0 + ai * HALF + m * 16;
                    const f32x4 v0 = acc[ai][0][m][0] * acc[ai][1][m][0], v1 = acc[ai][0][m][1] * acc[ai][1][m][1];
                    u32x4 w; w.x = cvtpk(v0[0], v0[1]); w.y = cvtpk(v0[2], v0[3]); w.z = cvtpk(v1[0], v1[1]); w.w = cvtpk(v1[2], v1[3]);
                    *(u32x4*)(CU + (size_t)row * DH + chb) = w;
                    if (row < MP) { const int t = row & (SEQ - 1); if (t >= SEQ - 2) { float* o = out + O_CP + (size_t)((row >> 11) * 2 + (t - (SEQ - 2))) * DH + chb; *(f32x4*)o = v0; *(f32x4*)(o + 4) = v1; } }
                    else { const int r2 = row - MP, t = r2 & (DS - 1); if (t >= DS - 2) { float* o = out + O_CS + (size_t)((r2 >> 5) * 2 + (t - (DS - 2))) * DH + chb; *(f32x4*)o = v0; *(f32x4*)(o + 4) = v1; } } }
        } else {
            const int chb = (pn - 24) * 128 + cl;
#pragma unroll
            for (int ai = 0; ai < 2; ++ai)
#pragma unroll
                for (int m = 0; m < 4; ++m) { const int row = row0 + ai * HALF + m * 16;
                    const f32x4 v0 = acc[ai][0][m][0] * silu4(acc[ai][1][m][0]), v1 = acc[ai][0][m][1] * silu4(acc[ai][1][m][1]);
                    u32x4 w; w.x = cvtpk(v0[0], v0[1]); w.y = cvtpk(v0[2], v0[3]); w.z = cvtpk(v1[0], v1[1]); w.w = cvtpk(v1[2], v1[3]);
                    *(u32x4*)(BG + (size_t)row * DH + chb) = w; }
        }
    }
};
struct Epi2 {
    static constexpr bool PERM = false, AFTER_DRAIN = false;
    const float* xp; const float* xs; float* y;
    __device__ __forceinline__ void operator()(const f32x4 (&acc)[2][2][4][2], const Unit& u, int wr, int wc, int fr, int fq) const {
        const int row0 = u.pm * BM + wr * 64 + fr, col0 = u.pn * BM + wc * 32 + 4 * fq;
#pragma unroll
        for (int ai = 0; ai < 2; ++ai)
#pragma unroll
            for (int m = 0; m < 4; ++m) { const int row = row0 + ai * HALF + m * 16;
                const float* xr = row < MP ? xp + (size_t)row * DM : xs + (size_t)(row - MP) * DM; float* yr = y + (size_t)row * DM;
#pragma unroll
                for (int bj = 0; bj < 2; ++bj)
#pragma unroll
                    for (int n = 0; n < 2; ++n) { const int col = col0 + bj * HALF + n * 16; *(f32x4*)(yr + col) = acc[ai][bj][m][n] + *(const f32x4*)(xr + col); } }
    }
};

template <class Epi, class Sched, bool ALIGN_EPI = false, bool SP2 = false>
__device__ __forceinline__ void gemm_phase(PG8_LAS unsigned char* lds, const Gemm g, const Sched& S, const Epi& E) {
    const int tid = threadIdx.x, wid = __builtin_amdgcn_readfirstlane(tid >> 6), lane = tid & 63, wr = wid >> 2, wc = wid & 3, fr = lane & 15, fq = lane >> 4;
    const int K = g.K, nt = K / BK;
    unsigned voffA[2], voffB[2];
#pragma unroll
    for (int i = 0; i < 2; ++i) { int R, C; stage_rc(tid * 16 + i * 8192, R, C); const int Rb = Epi::PERM ? ((R & ~31) + perm32(R & 31)) : R;
        voffA[i] = (unsigned)(R * K + C) * 2u; voffB[i] = (unsigned)(Rb * K + C) * 2u; }
    const size_t kstep = (size_t)(BK * 2);
    const size_t hstep = (size_t)HALF * K * 2;
    const size_t tstep = 2 * hstep;
    const unsigned ldsw = (unsigned)wid * 1024u;
    const int aoff = lds_byte(wr * 64 + fr, fq * 8), boff = lds_byte(wc * 32 + fr, fq * 8);
#define PG8_SA(b, h) (((b) * 2 + (h)) * HTB)
#define PG8_SB(b, h) ((4 + (b) * 2 + (h)) * HTB)
#define PG8_STAGE(bufoff, gbase, voff) do { _Pragma("unroll") for (int _i = 0; _i < 2; ++_i) \
        __builtin_amdgcn_global_load_lds((const unsigned*)((const char*)(gbase) + (voff)[_i]), (PG8_LAS unsigned*)(lds + (bufoff) + ldsw + _i * 8192), 16, 0, 0); } while (0)
#define PG8_LDA(dst, b, h) do { _Pragma("unroll") for (int m = 0; m < 4; ++m) _Pragma("unroll") for (int k = 0; k < 2; ++k) dst[m][k] = *(const PG8_LAS bf16x8*)(lds + PG8_SA(b, h) + aoff + m * 2048 + k * 1024); } while (0)
#define PG8_LDB(dst, b, h) do { _Pragma("unroll") for (int n = 0; n < 2; ++n) _Pragma("unroll") for (int k = 0; k < 2; ++k) dst[n][k] = *(const PG8_LAS bf16x8*)(lds + PG8_SB(b, h) + boff + n * 2048 + k * 1024); } while (0)
#define PG8_MMA(ai, bj, At, Bt) do { __builtin_amdgcn_s_setprio(1); _Pragma("unroll") for (int m = 0; m < 4; ++m) _Pragma("unroll") for (int n = 0; n < 2; ++n) _Pragma("unroll") for (int k = 0; k < 2; ++k) \
        acc[ai][bj][m][n] = __builtin_amdgcn_mfma_f32_16x16x32_bf16(Bt[n][k], At[m][k], acc[ai][bj][m][n], 0, 0, 0); __builtin_amdgcn_s_setprio(0); } while (0)
#define PG8_WAIT_V(n) asm volatile("s_waitcnt vmcnt(" #n ")" ::: "memory")
#define PG8_WAIT_L(n) asm volatile("s_waitcnt lgkmcnt(" #n ")" ::: "memory")
#define PG8_BAR __builtin_amdgcn_s_barrier()
#define PG8_SCHED __builtin_amdgcn_sched_barrier(0)
    Unit cur, nxt; int ui = 0;
    if (!S.next(0, cur)) return;
    f32x4 acc[2][2][4][2];
#pragma unroll
    for (int a = 0; a < 2; ++a)
#pragma unroll
        for (int b = 0; b < 2; ++b)
#pragma unroll
            for (int m = 0; m < 4; ++m)
#pragma unroll
                for (int n = 0; n < 2; ++n) acc[a][b][m][n] = (f32x4){0.f, 0.f, 0.f, 0.f};
    bf16x8 At[4][2], B0[2][2], B1[2][2];
    const char* cA = (const char*)g.A + (size_t)cur.pm * tstep; const char* cB = (const char*)g.Bt + (size_t)cur.pn * tstep;
    S.a_ready(cur);
    if constexpr (SP2) {
        PG8_STAGE(PG8_SB(0, 0), cB, voffB); PG8_STAGE(PG8_SB(0, 1), cB + hstep, voffB); PG8_STAGE(PG8_SA(0, 0), cA, voffA); PG8_STAGE(PG8_SA(0, 1), cA + hstep, voffA);
        if (wr == 1) PG8_BAR;
        PG8_WAIT_V(2); PG8_BAR;
        PG8_STAGE(PG8_SB(1, 0), cB + kstep, voffB); PG8_STAGE(PG8_SA(1, 0), cA + kstep, voffA); PG8_STAGE(PG8_SB(1, 1), cB + hstep + kstep, voffB);
        PG8_WAIT_V(6); PG8_BAR;
    } else {
        PG8_STAGE(PG8_SB(0, 0), cB, voffB); PG8_STAGE(PG8_SA(0, 0), cA, voffA); PG8_STAGE(PG8_SB(0, 1), cB + hstep, voffB); PG8_STAGE(PG8_SA(0, 1), cA + hstep, voffA);
        if (wr == 1) PG8_BAR;
        PG8_WAIT_V(4); PG8_BAR;
        PG8_STAGE(PG8_SB(1, 0), cB + kstep, voffB); PG8_STAGE(PG8_SA(1, 0), cA + kstep, voffA); PG8_STAGE(PG8_SB(1, 1), cB + hstep + kstep, voffB);
        PG8_WAIT_V(6); PG8_BAR;
    }
    for (;;) {
        const bool has_next = S.next(ui + 1, nxt);
        const char* nA = has_next ? (const char*)g.A + (size_t)nxt.pm * tstep : cA; const char* nB = has_next ? (const char*)g.Bt + (size_t)nxt.pn * tstep : cB;
        for (int t = 0; t < nt; t += 2) {
            const bool last = (t == nt - 2);
            const char* a1 = cA + (size_t)(t + 1) * kstep;
            const char* a2 = last ? nA : cA + (size_t)(t + 2) * kstep; const char* b2 = last ? nB : cB + (size_t)(t + 2) * kstep;
            const char* a3 = a2 + kstep; const char* b3 = b2 + kstep;
            if (last && has_next) S.a_ready(nxt);
            if constexpr (SP2) {
            PG8_LDB(B0, 0, 0); PG8_LDB(B1, 0, 1); PG8_SCHED; PG8_LDA(At, 0, 0); PG8_STAGE(PG8_SA(1, 1), a1 + hstep, voffA);
            PG8_WAIT_V(8); PG8_WAIT_L(0); PG8_BAR; PG8_MMA(0, 0, At, B0); PG8_MMA(0, 1, At, B1); PG8_BAR; PG8_SCHED;
            PG8_LDA(At, 0, 1); PG8_STAGE(PG8_SB(0, 0), b2, voffB); PG8_STAGE(PG8_SB(0, 1), b2 + hstep, voffB); PG8_STAGE(PG8_SA(0, 0), a2, voffA);
            PG8_WAIT_V(8); PG8_WAIT_L(0); PG8_BAR; PG8_MMA(1, 0, At, B0); PG8_MMA(1, 1, At, B1); PG8_BAR; PG8_SCHED;
            PG8_LDB(B0, 1, 0); PG8_LDB(B1, 1, 1); PG8_SCHED; PG8_LDA(At, 1, 0); PG8_STAGE(PG8_SA(0, 1), a2 + hstep, voffA);
            PG8_WAIT_V(8); PG8_WAIT_L(0); PG8_BAR; PG8_MMA(0, 0, At, B0); PG8_MMA(0, 1, At, B1); PG8_BAR; PG8_SCHED;
            PG8_LDA(At, 1, 1); PG8_STAGE(PG8_SB(1, 0), b3, voffB); PG8_STAGE(PG8_SB(1, 1), b3 + hstep, voffB); PG8_STAGE(PG8_SA(1, 0), a3, voffA);
            PG8_WAIT_V(8); PG8_WAIT_L(0); PG8_BAR; PG8_MMA(1, 0, At, B0); PG8_MMA(1, 1, At, B1); PG8_BAR; PG8_SCHED;
            } else {
            PG8_LDB(B0, 0, 0); PG8_SCHED; PG8_LDA(At, 0, 0); PG8_STAGE(PG8_SA(1, 1), a1 + hstep, voffA);
            PG8_WAIT_L(8); PG8_BAR; PG8_WAIT_L(0); PG8_MMA(0, 0, At, B0); PG8_BAR; PG8_SCHED;
            PG8_LDB(B1, 0, 1); PG8_STAGE(PG8_SB(0, 0), b2, voffB);
            PG8_BAR; PG8_WAIT_L(0); PG8_MMA(0, 1, At, B1); PG8_BAR;
            PG8_LDA(At, 0, 1); PG8_STAGE(PG8_SA(0, 0), a2, voffA);
            PG8_BAR; PG8_WAIT_L(0); PG8_MMA(1, 0, At, B0); PG8_BAR; PG8_SCHED;
            PG8_STAGE(PG8_SB(0, 1), b2 + hstep, voffB);
            PG8_WAIT_V(6); PG8_BAR; PG8_MMA(1, 1, At, B1); PG8_BAR;
            PG8_LDB(B0, 1, 0); PG8_SCHED; PG8_LDA(At, 1, 0); PG8_STAGE(PG8_SA(0, 1), a2 + hstep, voffA);
            PG8_WAIT_L(8); PG8_BAR; PG8_WAIT_L(0); PG8_MMA(0, 0, At, B0); PG8_BAR; PG8_SCHED;
            PG8_LDB(B1, 1, 1); PG8_STAGE(PG8_SB(1, 0), b3, voffB);
            PG8_BAR; PG8_WAIT_L(0); PG8_MMA(0, 1, At, B1); PG8_BAR;
            PG8_LDA(At, 1, 1); PG8_STAGE(PG8_SA(1, 0), a3, voffA);
            PG8_BAR; PG8_WAIT_L(0); PG8_MMA(1, 0, At, B0); PG8_BAR; PG8_SCHED;
            PG8_STAGE(PG8_SB(1, 1), b3 + hstep, voffB);
            PG8_WAIT_V(6); PG8_BAR; PG8_MMA(1, 1, At, B1); PG8_BAR;
            }
        }
        if constexpr (ALIGN_EPI) { if (wr == 0) PG8_BAR; }
        if constexpr (!Epi::AFTER_DRAIN) { E(acc, cur, wr, wc, fr, fq); S.done(cur); }
        if (!has_next) break;
#pragma unroll
        for (int a = 0; a < 2; ++a)
#pragma unroll
            for (int b = 0; b < 2; ++b)
#pragma unroll
                for (int m = 0; m < 4; ++m)
#pragma unroll
                    for (int n = 0; n < 2; ++n) acc[a][b][m][n] = (f32x4){0.f, 0.f, 0.f, 0.f};
        cur = nxt; cA = nA; cB = nB; ++ui;
        if constexpr (ALIGN_EPI) { if (wr == 1) PG8_BAR; }
    }
    PG8_WAIT_V(0);
    if constexpr (!ALIGN_EPI) { if (wr == 0) PG8_BAR; }
    PG8_BAR;
    if constexpr (Epi::AFTER_DRAIN) { E.fused(acc, cur, wr, wc, fr, fq, lds, wid, lane); S.done(cur); }
#undef PG8_SA
#undef PG8_SB
#undef PG8_STAGE
#undef PG8_LDA
#undef PG8_LDB
#undef PG8_MMA
#undef PG8_WAIT_V
#undef PG8_WAIT_L
#undef PG8_BAR
#undef PG8_SCHED
}
}
constexpr int NWAVES = 8;
constexpr int RING_OFF = 0, RING_BYTES = 131072;
constexpr int LDSCTL_OFF = 155648, MISC_OFF = LDSCTL_OFF + 320;
constexpr int XCH_OFF = LDSCTL_OFF + 1024;
constexpr int LDS_BYTES = 159744;
static_assert(XCH_OFF + 1024 <= LDS_BYTES && MISC_OFF + 128 <= XCH_OFF, "LDS map");

typedef unsigned v4u __attribute__((ext_vector_type(4)));
typedef unsigned v2u __attribute__((ext_vector_type(2)));
typedef float f32x4 __attribute__((ext_vector_type(4)));
typedef short bf16x8 __attribute__((ext_vector_type(8)));
typedef short s16x4 __attribute__((ext_vector_type(4)));
typedef float f32x16 __attribute__((ext_vector_type(16)));
typedef GAS unsigned gu32;
#define RLX_AGENT __ATOMIC_RELAXED, __HIP_MEMORY_SCOPE_AGENT
#define LDS_WAIT() asm volatile("s_waitcnt lgkmcnt(0)" ::: "memory")
#define VM_WAIT() asm volatile("s_waitcnt vmcnt(0)" ::: "memory")
#define CFENCE() do { asm volatile("" ::: "memory"); __builtin_amdgcn_wave_barrier(); asm volatile("" ::: "memory"); } while (0)
using pg8::cvtpk;
__device__ __forceinline__ float bf2f(unsigned b) { return __uint_as_float(b << 16); }
__device__ __forceinline__ float bflo(unsigned w) { return __uint_as_float(w << 16); }
__device__ __forceinline__ float bfhi(unsigned w) { return __uint_as_float(w & 0xffff0000u); }

#define XB_TMO      128
#define XB_XCNT(j)  (256  + 64 * (j))
#define XB_XSUB(j)  (1280 + 64 * (j))
#define XB_XGEN(j)  (2304 + 64 * (j))
#define XB_TOP      3328
#define XB_TOPGEN   3392
#define XCD_BAR_WORDS 3456
#define XB_SPIN_CAP (1u << 18)

__device__ __forceinline__ unsigned xb_ld(unsigned* p)              { return __hip_atomic_load(p, __ATOMIC_RELAXED, __HIP_MEMORY_SCOPE_AGENT); }
__device__ __forceinline__ unsigned xb_add(unsigned* p, unsigned v) { return __hip_atomic_fetch_add(p, v, __ATOMIC_RELAXED, __HIP_MEMORY_SCOPE_AGENT); }
__device__ __forceinline__ unsigned xb_xcc_id() { return (unsigned)__builtin_amdgcn_s_getreg((3 << 11) | 20) & 0xFu; }
#define XB_SPIN(cond, bar) do { unsigned _sp = 0; while (cond) { __builtin_amdgcn_s_sleep(1); \
    if ((++_sp & 255u) == 0u) { if (xb_ld(&(bar)[XB_TMO])) break; if (_sp > XB_SPIN_CAP) { atomicAdd(&(bar)[XB_TMO], 1u); break; } } } } while (0)

struct XcdBarrier {
    unsigned* bar; unsigned x;
    volatile LAS unsigned* st;
};

__device__ __forceinline__ XcdBarrier xcd_barrier_post(unsigned* bar, volatile LAS unsigned* st) {
    XcdBarrier b; b.bar = bar; b.x = xb_xcc_id(); b.st = st;
    if (threadIdx.x == 0) (void)xb_add(&bar[XB_XCNT(b.x)], 1u);
    return b;
}
__device__ __forceinline__ void xcd_barrier_complete(unsigned* bar, unsigned x, unsigned& nloc, unsigned& nx) {
    const unsigned G = gridDim.x * gridDim.y * gridDim.z;
    unsigned sum, cnt, mine, sp = 0u;
    for (;;) {
        sum = 0u; cnt = 0u; mine = 0u;
#pragma unroll
        for (unsigned j = 0; j < 16; ++j) { const unsigned c = xb_ld(&bar[XB_XCNT(j)]); sum += c; cnt += (c > 0u) ? 1u : 0u; mine = (j == x) ? c : mine; }
        if (sum == G) break;
        __builtin_amdgcn_s_sleep(1);
        if ((++sp & 255u) == 0u) { if (xb_ld(&bar[XB_TMO])) break; if (sp > XB_SPIN_CAP) { atomicAdd(&bar[XB_TMO], 1u); break; } }
    }
    nloc = mine > 0u ? mine : 1u; nx = cnt > 0u ? cnt : 1u;
}

__device__ __forceinline__ void xcd_barrier(const XcdBarrier& b) {
    asm volatile("s_waitcnt vmcnt(0)" ::: "memory");
    __syncthreads();
    if (threadIdx.x == 0) {
        unsigned* bar = b.bar;
        __builtin_amdgcn_s_waitcnt(0);
        unsigned nloc = b.st[0], nx = b.st[1];
        if (nloc == 0u) { xcd_barrier_complete(bar, b.x, nloc, nx); b.st[0] = nloc; b.st[1] = nx; }
        const unsigned old = xb_add(&bar[XB_XSUB(b.x)], 1u);
        const unsigned gen = old / nloc;
        if (old + 1u == (gen + 1u) * nloc) {
            __builtin_amdgcn_fence(__ATOMIC_RELEASE, "agent");
            asm volatile("s_waitcnt vmcnt(0)" ::: "memory");
            const unsigned og = xb_add(&bar[XB_TOP], 1u);
            const unsigned tg = og / nx;
            if (og + 1u == (tg + 1u) * nx) xb_add(&bar[XB_TOPGEN], 1u);
            else XB_SPIN(xb_ld(&bar[XB_TOPGEN]) == tg, bar);
            __builtin_amdgcn_fence(__ATOMIC_ACQUIRE, "agent");
            xb_add(&bar[XB_XGEN(b.x)], 1u);
            asm volatile("s_waitcnt vmcnt(0)" ::: "memory");
        } else {
            XB_SPIN(xb_ld(&bar[XB_XGEN(b.x)]) == gen, bar);
            __builtin_amdgcn_fence(__ATOMIC_ACQUIRE, "agent");
            asm volatile("s_waitcnt vmcnt(0)" ::: "memory");
        }
    }
    __syncthreads();
}

struct Frame {
    LAS unsigned char* lds;
    volatile LAS unsigned* MISC;
    gu32* ctl;
    int tid, lane, wave;
    int vcu, G;
    const float *xp, *xs, *ck, *cv, *sconv, *norm_g, *w_in, *conv_w, *w_out, *final_g; float* out;
    bf16 *Win_t, *Wout_t, *H, *Qb, *Kb, *Vb, *Gs, *CU, *BG, *MIX;
};

__device__ __forceinline__ float wave_sum(float v) {
#pragma unroll
    for (int o = 1; o < 64; o <<= 1) v += __shfl_xor(v, o);
    return v;
}
__device__ __forceinline__ void p0_transpose_item(const float* W, int K, int N, bf16* WT, int k0, int n0, int drow0, LAS float* scr, int lane) {
#pragma unroll 8
    for (int i = 0; i < 32; ++i) { const int kk = 2 * i + (lane >> 5); scr[kk * 33 + (lane & 31)] = W[(size_t)(k0 + kk) * N + n0 + (lane & 31)]; }
    LDS_WAIT(); CFENCE();
    const int c = lane & 7;
#pragma unroll
    for (int j = 0; j < 4; ++j) { const int n = (lane >> 3) + 8 * j; const LAS float* s = scr + (8 * c) * 33 + n;
        v4u o; o.x = cvtpk(s[0 * 33], s[1 * 33]); o.y = cvtpk(s[2 * 33], s[3 * 33]); o.z = cvtpk(s[4 * 33], s[5 * 33]); o.w = cvtpk(s[6 * 33], s[7 * 33]);
        *(GAS v4u*)(WT + (size_t)(drow0 + n) * K + k0 + 8 * c) = o; }
    LDS_WAIT(); CFENCE();
}
__device__ __forceinline__ int win_dest_row(int n) {
    if (n < 4096) return n;
    const int s = (n - 4096) >> 10, ch = (n - 4096) & 1023, j = ch >> 7, cc = ch & 127;
    const int tile = (s == 1 || s == 2) ? 16 + j : 24 + j, half = (s == 2 || s == 3) ? 128 : 0;
    return tile * 256 + half + cc;
}
__device__ __forceinline__ void rms_row_to_bf16(const float* xrow, const float* g, bf16* orow, int lane) {
    const GAS f32x4* xr = (const GAS f32x4*)xrow + lane; const GAS f32x4* gr = (const GAS f32x4*)g + lane;
    f32x4 v[8]; float s = 0.f;
#pragma unroll
    for (int j = 0; j < 8; ++j) { v[j] = xr[64 * j]; s += (v[j].x * v[j].x + v[j].y * v[j].y) + (v[j].z * v[j].z + v[j].w * v[j].w); }
    const float r = 1.0f / sqrtf(wave_sum(s) * (1.f / DM) + EPS);
    GAS v2u* o8 = (GAS v2u*)orow + lane;
#pragma unroll
    for (int j = 0; j < 8; ++j) { const f32x4 gg = gr[64 * j]; v2u w; w.x = cvtpk((v[j].x * r) * gg.x, (v[j].y * r) * gg.y); w.y = cvtpk((v[j].z * r) * gg.z, (v[j].w * r) * gg.w); o8[64 * j] = w; }
}
__device__ __forceinline__ void p0_prologue(Frame& F) {
    LAS float* scr = (LAS float*)(F.lds + RING_OFF + F.wave * 16384);
    const int gw = F.vcu * NWAVES + F.wave, NGW = F.G * NWAVES;
    constexpr int I_IN = (DM / 64) * (DIN / 32), I_OUT = (DM / 64) * (DM / 32);
    for (int it = gw; it < I_IN + I_OUT; it += NGW) {
        if (it < I_IN) { const int kb = it / (DIN / 32), nb = it % (DIN / 32); p0_transpose_item(F.w_in, DM, DIN, F.Win_t, 64 * kb, 32 * nb, win_dest_row(32 * nb), scr, F.lane); }
        else { const int r = it - I_IN, kb = r / (DM / 32), nb = r % (DM / 32); p0_transpose_item(F.w_out, DM, DM, F.Wout_t, 64 * kb, 32 * nb, 32 * nb, scr, F.lane); }
    }
    for (int m = gw; m < MT; m += NGW) rms_row_to_bf16(m < MP ? F.xp + (size_t)m * DM : F.xs + (size_t)(m - MP) * DM, F.norm_g, F.H + (size_t)m * DM, F.lane);
}
__device__ __forceinline__ void p4_final_norm(Frame& F) {
    const int gw = F.vcu * NWAVES + F.wave, NGW = F.G * NWAVES;
    for (int m = gw; m < MT; m += NGW) {
        GAS f32x4* yr = (GAS f32x4*)(F.out + O_Y + (size_t)m * DM) + F.lane; const GAS f32x4* gr = (const GAS f32x4*)F.final_g + F.lane;
        f32x4 v[8]; float s = 0.f;
#pragma unroll
        for (int j = 0; j < 8; ++j) { v[j] = yr[64 * j]; s += (v[j].x * v[j].x + v[j].y * v[j].y) + (v[j].z * v[j].z + v[j].w * v[j].w); }
        const float r = 1.0f / sqrtf(wave_sum(s) * (1.f / DM) + EPS);
#pragma unroll
        for (int j = 0; j < 8; ++j) { const f32x4 gg = gr[64 * j]; f32x4 o; o.x = (v[j].x * r) * gg.x; o.y = (v[j].y * r) * gg.y; o.z = (v[j].z * r) * gg.z; o.w = (v[j].w * r) * gg.w; yr[64 * j] = o; }
    }
}
__device__ __forceinline__ void unpack8(const v4u w, float (&f)[8]) { f[0] = bflo(w.x); f[1] = bfhi(w.x); f[2] = bflo(w.y); f[3] = bfhi(w.y); f[4] = bflo(w.z); f[5] = bfhi(w.z); f[6] = bflo(w.w); f[7] = bfhi(w.w); }
__device__ __forceinline__ void p2_convmix(Frame& F) {
    const int gw = F.vcu * NWAVES + F.wave, NGW = F.G * NWAVES;
    for (int item = gw; item < MT * 2; item += NGW) {
        const int row = item >> 1, ch = (item & 1) * 512 + F.lane * 8;
        const bool samp = row >= MP; const int t = samp ? ((row - MP) & (DS - 1)) : (row & (SEQ - 1)); const int b = samp ? ((row - MP) >> 5) : (row >> 11);
        float c0[8], c1[8], c2[8], g[8];
        unpack8(*(const GAS v4u*)(F.CU + (size_t)row * DH + ch), c0);
        unpack8(*(const GAS v4u*)(F.BG + (size_t)row * DH + ch), g);
        if (t >= 1) unpack8(*(const GAS v4u*)(F.CU + (size_t)(row - 1) * DH + ch), c1);
        else if (samp) { const f32x4 a = *(const GAS f32x4*)(F.sconv + (size_t)(b * 2 + 1) * DH + ch), bq = *(const GAS f32x4*)(F.sconv + (size_t)(b * 2 + 1) * DH + ch + 4);
            c1[0] = a.x; c1[1] = a.y; c1[2] = a.z; c1[3] = a.w; c1[4] = bq.x; c1[5] = bq.y; c1[6] = bq.z; c1[7] = bq.w; }
        else {
#pragma unroll
            for (int i = 0; i < 8; ++i) c1[i] = 0.f; }
        if (t >= 2) unpack8(*(const GAS v4u*)(F.CU + (size_t)(row - 2) * DH + ch), c2);
        else if (samp) { const f32x4 a = *(const GAS f32x4*)(F.sconv + (size_t)(b * 2 + t) * DH + ch), bq = *(const GAS f32x4*)(F.sconv + (size_t)(b * 2 + t) * DH + ch + 4);
            c2[0] = a.x; c2[1] = a.y; c2[2] = a.z; c2[3] = a.w; c2[4] = bq.x; c2[5] = bq.y; c2[6] = bq.z; c2[7] = bq.w; }
        else {
#pragma unroll
            for (int i = 0; i < 8; ++i) c2[i] = 0.f; }
        float w0[8], w1[8], w2[8];
        { const GAS f32x4* p = (const GAS f32x4*)(F.conv_w + ch); const f32x4 a = p[0], bq = p[1]; w0[0] = a.x; w0[1] = a.y; w0[2] = a.z; w0[3] = a.w; w0[4] = bq.x; w0[5] = bq.y; w0[6] = bq.z; w0[7] = bq.w; }
        { const GAS f32x4* p = (const GAS f32x4*)(F.conv_w + DH + ch); const f32x4 a = p[0], bq = p[1]; w1[0] = a.x; w1[1] = a.y; w1[2] = a.z; w1[3] = a.w; w1[4] = bq.x; w1[5] = bq.y; w1[6] = bq.z; w1[7] = bq.w; }
        { const GAS f32x4* p = (const GAS f32x4*)(F.conv_w + 2 * DH + ch); const f32x4 a = p[0], bq = p[1]; w2[0] = a.x; w2[1] = a.y; w2[2] = a.z; w2[3] = a.w; w2[4] = bq.x; w2[5] = bq.y; w2[6] = bq.z; w2[7] = bq.w; }
        float o[8];
#pragma unroll
        for (int i = 0; i < 8; ++i) o[i] = g[i] * ((w0[i] * c2[i] + w1[i] * c1[i]) + w2[i] * c0[i]);
        v4u w; w.x = cvtpk(o[0], o[1]); w.y = cvtpk(o[2], o[3]); w.z = cvtpk(o[4], o[5]); w.w = cvtpk(o[6], o[7]);
        *(GAS v4u*)(F.MIX + (size_t)row * DM + DH + ch) = w;
    }
}

namespace sb {
constexpr float EXIT_THR = -160.0f;
constexpr int KST = 272, VST = 320;
constexpr int QIMG_OFF = 32 * VST;
constexpr int ATT_REGION = 19456;
static_assert(QIMG_OFF + 32 * KST <= ATT_REGION && 8 * ATT_REGION <= LDSCTL_OFF, "attention LDS map");
typedef __amdgpu_buffer_rsrc_t rsrc_t;
__device__ __forceinline__ rsrc_t mk_rsrc(const void* p, unsigned bytes) { return __builtin_amdgcn_make_buffer_rsrc((void*)p, (short)0, (int)bytes, 0x00020000); }
__device__ __forceinline__ int crow(int r, int hi) { return (r & 3) + 8 * (r >> 2) + 4 * hi; }
__device__ __forceinline__ s16x4 vtr(LAS const char* p) { typedef short v4i16_t __attribute__((ext_vector_type(4))); return __builtin_bit_cast(s16x4, __builtin_amdgcn_ds_read_tr16_b64_v4i16((LAS v4i16_t*)p)); }

__device__ __forceinline__ void ld_bf16(v4u (&R)[8], rsrc_t rs, int soff, int lane) {
    const int voff = ((lane >> 4) * DH + (lane & 15) * 8) * 2;
#pragma unroll
    for (int i = 0; i < 8; ++i) R[i] = __builtin_bit_cast(v4u, __builtin_amdgcn_raw_buffer_load_b128(rs, voff, soff + i * (4 * DH * 2), 0));
}
__device__ __forceinline__ void st_k_bf16(LAS char* img, const v4u (&R)[8], int lane) {
    LAS char* p = img + (lane >> 4) * KST + (lane & 15) * 16;
#pragma unroll
    for (int i = 0; i < 8; ++i) *(LAS v4u*)(p + i * 4 * KST) = R[i];
}
__device__ __forceinline__ void st_v_bf16(LAS char* img, const v4u (&R)[8], int lane) {
    LAS char* p = img + (lane >> 4) * VST + (lane & 15) * 16;
#pragma unroll
    for (int i = 0; i < 8; ++i) *(LAS v4u*)(p + i * 4 * VST) = R[i];
}
__device__ __forceinline__ void ld_f32(f32x4 (&R)[16], rsrc_t rs, int soff, int lane) {
    const int voff = ((lane >> 5) * DH + (lane & 31) * 4) * 4;
#pragma unroll
    for (int i = 0; i < 16; ++i) R[i] = __builtin_bit_cast(f32x4, __builtin_amdgcn_raw_buffer_load_b128(rs, voff, soff + i * (2 * DH * 4), 0));
}
__device__ __forceinline__ void st_k_f32(LAS char* img, const f32x4 (&R)[16], int lane) {
    LAS char* p = img + (lane >> 5) * KST + (lane & 31) * 8;
#pragma unroll
    for (int i = 0; i < 16; ++i) { v2u w; w.x = cvtpk(R[i].x, R[i].y); w.y = cvtpk(R[i].z, R[i].w); *(LAS v2u*)(p + i * 2 * KST) = w; }
}
__device__ __forceinline__ void st_v_f32(LAS char* img, const f32x4 (&R)[16], int lane) {
    LAS char* p = img + (lane >> 5) * VST + (lane & 31) * 8;
#pragma unroll
    for (int i = 0; i < 16; ++i) { v2u w; w.x = cvtpk(R[i].x, R[i].y); w.y = cvtpk(R[i].z, R[i].w); *(LAS v2u*)(p + i * 2 * VST) = w; }
}
template <bool MASK>
__device__ __forceinline__ void s_part(LAS const char* img, LAS const char* Qimg, float& run, bf16x8& wf0, bf16x8& wf1, int r32, int hi) {
    f32x16 st;
#pragma unroll
    for (int i = 0; i < 16; ++i) st[i] = 0.f;
    const int fo = r32 * KST + hi * 16;
#pragma unroll
    for (int s = 0; s < 8; ++s) { const bf16x8 kf = *(LAS const bf16x8*)(img + fo + 32 * s), qf = *(LAS const bf16x8*)(Qimg + fo + 32 * s); st = __builtin_amdgcn_mfma_f32_32x32x16_bf16(kf, qf, st, 0, 0, 0); }
    float lb[16], ex[16], T[4];
#pragma unroll
    for (int i = 0; i < 16; ++i) { const float z = st[i]; const float e = __builtin_amdgcn_exp2f(-__builtin_fabsf(z)); const float lp = __builtin_amdgcn_logf(1.0f + e);
        float a = __builtin_fminf(z, 0.f) - lp, l1 = __builtin_fminf(-z, 0.f) - lp;
        if (MASK) { if (crow(i, hi) >= r32) { a = -INFINITY; l1 = 0.f; } }
        lb[i] = a; ex[i] = l1; }
#pragma unroll
    for (int g = 0; g < 4; ++g) { const float l0 = ex[4 * g], l1 = ex[4 * g + 1], l2 = ex[4 * g + 2], l3 = ex[4 * g + 3];
        ex[4 * g + 3] = 0.f; ex[4 * g + 2] = l3; ex[4 * g + 1] = l3 + l2; ex[4 * g] = (l3 + l2) + l1; T[g] = ((l3 + l2) + l1) + l0; }
    float P[4], U[4];
#pragma unroll
    for (int g = 0; g < 4; ++g) { P[g] = __shfl_xor(T[g], 32); U[g] = T[g] + P[g]; }
    const float A2 = U[3], A1 = U[3] + U[2], A0 = A1 + U[1], tot = A0 + U[0];
    float off[4]; off[3] = run; off[2] = run + A2; off[1] = run + A1; off[0] = run + A0;
    if (hi == 0) {
#pragma unroll
        for (int g = 0; g < 4; ++g) off[g] += P[g]; }
    float w[16];
#pragma unroll
    for (int i = 0; i < 16; ++i) w[i] = __builtin_amdgcn_exp2f(lb[i] + (off[i >> 2] + ex[i]));
    run += tot;
    v4u a, b; a.x = cvtpk(w[0], w[1]); a.y = cvtpk(w[2], w[3]); a.z = cvtpk(w[4], w[5]); a.w = cvtpk(w[6], w[7]);
    b.x = cvtpk(w[8], w[9]); b.y = cvtpk(w[10], w[11]); b.z = cvtpk(w[12], w[13]); b.w = cvtpk(w[14], w[15]);
    wf0 = __builtin_bit_cast(bf16x8, a); wf1 = __builtin_bit_cast(bf16x8, b);
}
__device__ __forceinline__ void pv_part(LAS const char* img, f32x16 (&o)[4], const bf16x8 wf0, const bf16x8 wf1, int lane) {
    const int i = lane & 15, q4 = i >> 2, p = i & 3, hi = lane >> 5;
    LAS const char* vb = img + (4 * hi + q4) * VST + 32 * ((lane >> 4) & 1) + 8 * p;
#pragma unroll
    for (int dblk = 0; dblk < 4; ++dblk)
#pragma unroll
        for (int s = 0; s < 2; ++s) {
            const s16x4 lo = vtr(vb + 16 * s * VST + 64 * dblk), hh = vtr(vb + (16 * s + 8) * VST + 64 * dblk);
            const bf16x8 vf = (bf16x8){lo[0], lo[1], lo[2], lo[3], hh[0], hh[1], hh[2], hh[3]};
            o[dblk] = __builtin_amdgcn_mfma_f32_32x32x16_bf16(vf, s ? wf1 : wf0, o[dblk], 0, 0, 0); }
}
template <bool MASK>
__device__ __forceinline__ void tile_bf16(v4u (&R)[8], rsrc_t rk, rsrc_t rv, int vo, int kno, f32x16 (&o)[4], float& run, LAS char* img, LAS char* Qimg, int lane) {
    st_k_bf16(img, R, lane);
    ld_bf16(R, rv, vo, lane);
    CFENCE();
    bf16x8 wf0, wf1;
    s_part<MASK>(img, Qimg, run, wf0, wf1, lane & 31, lane >> 5);
    CFENCE();
    st_v_bf16(img, R, lane);
    ld_bf16(R, rk, kno, lane);
    CFENCE();
    pv_part(img, o, wf0, wf1, lane);
    CFENCE();
}
template <bool EARLY>
__device__ __forceinline__ void range_bf16(rsrc_t rk, rsrc_t rv, int off0, int tau_hi, int tau_lo, bool first_masked, f32x16 (&o)[4], float& run, LAS char* img, LAS char* Qimg, int lane) {
    if (tau_hi < tau_lo) return;
    constexpr int TB = 32 * DH * 2;
    v4u R[8];
    ld_bf16(R, rk, off0 + tau_hi * TB, lane);
    int tau = tau_hi;
    if (first_masked) { tile_bf16<true>(R, rk, rv, off0 + tau * TB, off0 + (tau > tau_lo ? tau - 1 : tau) * TB, o, run, img, Qimg, lane); --tau; }
    for (; tau >= tau_lo; --tau) {
        tile_bf16<false>(R, rk, rv, off0 + tau * TB, off0 + (tau > tau_lo ? tau - 1 : tau) * TB, o, run, img, Qimg, lane);
        if (EARLY) { if (__all(run < EXIT_THR)) break; }
    }
}
__device__ __forceinline__ void tile_f32(f32x4 (&R)[16], rsrc_t rk, rsrc_t rv, int vo, int kno, f32x16 (&o)[4], float& run, LAS char* img, LAS char* Qimg, int lane) {
    st_k_f32(img, R, lane);
    ld_f32(R, rv, vo, lane);
    CFENCE();
    bf16x8 wf0, wf1;
    s_part<false>(img, Qimg, run, wf0, wf1, lane & 31, lane >> 5);
    CFENCE();
    st_v_f32(img, R, lane);
    ld_f32(R, rk, kno, lane);
    CFENCE();
    pv_part(img, o, wf0, wf1, lane);
    CFENCE();
}
template <bool EARLY>
__device__ __forceinline__ void range_f32(rsrc_t rk, rsrc_t rv, int off0, int tau_hi, int tau_lo, f32x16 (&o)[4], float& run, LAS char* img, LAS char* Qimg, int lane) {
    if (tau_hi < tau_lo) return;
    constexpr int TB = 32 * DH * 4;
    f32x4 R[16];
    ld_f32(R, rk, off0 + tau_hi * TB, lane);
    for (int tau = tau_hi; tau >= tau_lo; --tau) {
        tile_f32(R, rk, rv, off0 + tau * TB, off0 + (tau > tau_lo ? tau - 1 : tau) * TB, o, run, img, Qimg, lane);
        if (EARLY) { if (__all(run < EXIT_THR)) break; }
    }
}
__device__ __forceinline__ void load_q(LAS char* Qimg, rsrc_t rq, int soff  , int lane) {
    v4u R[8]; ld_bf16(R, rq, soff, lane); st_k_bf16(Qimg, R, lane); CFENCE();
}
__device__ __forceinline__ void zero_o(f32x16 (&o)[4]) {
#pragma unroll
    for (int d = 0; d < 4; ++d)
#pragma unroll
        for (int i = 0; i < 16; ++i) o[d][i] = 0.f;
}
__device__ __forceinline__ void epi_store(const f32x16 (&o)[4], const bf16* Gs_row, bf16* MIX_row, int hi) {
#pragma unroll
    for (int dblk = 0; dblk < 4; ++dblk)
#pragma unroll
        for (int g = 0; g < 4; ++g) { const int d0 = 32 * dblk + 8 * g + 4 * hi; const v2u gg = *(const GAS v2u*)(Gs_row + d0);
            v2u w; w.x = cvtpk(o[dblk][4 * g] * bflo(gg.x), o[dblk][4 * g + 1] * bfhi(gg.x)); w.y = cvtpk(o[dblk][4 * g + 2] * bflo(gg.y), o[dblk][4 * g + 3] * bfhi(gg.y));
            *(GAS v2u*)(MIX_row + d0) = w; }
}
struct Ctx { const bf16 *Qb, *Kb, *Vb, *Gs; bf16* MIX; const float *ck, *cv; };

template <bool EARLY>
__device__ __forceinline__ void attn_phase(LAS unsigned char* lds, const Ctx& C, int vcu, int G, int wave, int lane) {
    LAS char* region = (LAS char*)lds + wave * ATT_REGION; LAS char* img = region; LAS char* Qimg = region + QIMG_OFF;
    LAS float* xch = (LAS float*)((LAS char*)lds + XCH_OFF);
    const int r32 = lane & 31, hi = lane >> 5;
    const rsrc_t rQ = mk_rsrc(C.Qb, (unsigned)MT * DH * 2), rK = mk_rsrc(C.Kb, (unsigned)MT * DH * 2), rV = mk_rsrc(C.Vb, (unsigned)MT * DH * 2);
    const rsrc_t rCK = mk_rsrc(C.ck, (unsigned)DB * PAST * DH * 4), rCV = mk_rsrc(C.cv, (unsigned)DB * PAST * DH * 4);
    for (int unit = vcu; unit < 256; unit += G) {
        {
            const int b = unit >> 3, h = unit & 7; const size_t qrow = (size_t)MP + 32 * b + r32;
            const int new0 = ((MP + 32 * b) * DH + h * HD) * 2;
            const int c0 = (b * PAST * DH + h * HD) * 4;
            load_q(Qimg, rQ, new0, lane);
            f32x16 o[4]; zero_o(o); float run = 0.f;
            if (wave == 7) {
                range_bf16<false>(rK, rV, new0, 0, 0, true, o, run, img, Qimg, lane);
                range_f32<EARLY>(rCK, rCV, c0, 31, 28, o, run, img, Qimg, lane);
            } else range_f32<EARLY>(rCK, rCV, c0, 4 * wave + 3, 4 * wave, o, run, img, Qimg, lane);
            if (hi == 0) xch[wave * 32 + r32] = run;
            __syncthreads();
            float fs = 0.f;
            for (int w2 = wave + 1; w2 < 8; ++w2) fs += xch[w2 * 32 + r32];
            const float f = __builtin_amdgcn_exp2f(fs);
            LAS float* rg = (LAS float*)region;
#pragma unroll
            for (int d = 0; d < 4; ++d)
#pragma unroll
                for (int i = 0; i < 16; ++i) rg[(d * 16 + i) * 64 + lane] = o[d][i] * f;
            __syncthreads();
            float res[8];
#pragma unroll
            for (int j = 0; j < 8; ++j) { float s = 0.f;
#pragma unroll
                for (int w2 = 0; w2 < 8; ++w2) s += ((LAS const float*)((LAS const char*)lds + w2 * ATT_REGION))[(8 * wave + j) * 64 + lane];
                res[j] = s; }
            const bf16* Gs_row = C.Gs + qrow * DH + h * HD; bf16* MIX_row = C.MIX + qrow * DM + h * HD;
#pragma unroll
            for (int jj = 0; jj < 2; ++jj) { const int d0 = 32 * (wave >> 1) + 8 * (2 * (wave & 1) + jj) + 4 * hi; const v2u gg = *(const GAS v2u*)(Gs_row + d0);
                v2u w; w.x = cvtpk(res[4 * jj] * bflo(gg.x), res[4 * jj + 1] * bfhi(gg.x)); w.y = cvtpk(res[4 * jj + 2] * bflo(gg.y), res[4 * jj + 3] * bfhi(gg.y));
                *(GAS v2u*)(MIX_row + d0) = w; }
            __syncthreads();
        }
        {
            const int bh = unit >> 3, b = bh >> 3, h = bh & 7, i = 4 * (unit & 7) + (wave & 3);
            const int s0 = (b * SEQ * DH + h * HD) * 2;
            constexpr int TB = 32 * DH * 2;
            f32x16 o[4]; float run;
            const int qt2 = 63 - i; const size_t qrow2 = (size_t)b * SEQ + 32 * qt2 + r32;
            if (wave < 4) {
                const size_t qrow1 = (size_t)b * SEQ + 32 * i + r32;
                load_q(Qimg, rQ, s0 + i * TB, lane); zero_o(o); run = 0.f;
                range_bf16<EARLY>(rK, rV, s0, i, 0, true, o, run, img, Qimg, lane);
                epi_store(o, C.Gs + qrow1 * DH + h * HD, C.MIX + qrow1 * DM + h * HD, hi);
                load_q(Qimg, rQ, s0 + qt2 * TB, lane); zero_o(o); run = 0.f;
                range_bf16<EARLY>(rK, rV, s0, 31 - i, 0, false, o, run, img, Qimg, lane);
            } else {
                load_q(Qimg, rQ, s0 + qt2 * TB, lane); zero_o(o); run = 0.f;
                range_bf16<EARLY>(rK, rV, s0, qt2, 32 - i, true, o, run, img, Qimg, lane);
                if (hi == 0) xch[wave * 32 + r32] = run;
            }
            __syncthreads();
            LAS float* rg = (LAS float*)((LAS char*)lds + (wave & 3) * ATT_REGION);
            if (wave < 4) {
                const float f = __builtin_amdgcn_exp2f(xch[(wave + 4) * 32 + r32]);
#pragma unroll
                for (int d = 0; d < 4; ++d)
#pragma unroll
                    for (int k = 0; k < 16; ++k) rg[(d * 16 + k) * 64 + lane] = o[d][k] * f;
            }
            __syncthreads();
            if (wave >= 4) {
#pragma unroll
                for (int d = 0; d < 4; ++d)
#pragma unroll
                    for (int k = 0; k < 16; ++k) o[d][k] += rg[(d * 16 + k) * 64 + lane];
                epi_store(o, C.Gs + qrow2 * DH + h * HD, C.MIX + qrow2 * DM + h * HD, hi);
            }
            __syncthreads();
        }
    }
}
}

struct Args { const float* in[10]; float* out; unsigned char* ws; int ph_mask; int pad; };
#ifndef SB_EARLY
#define SB_EARLY false
#endif
__global__ void __launch_bounds__(NWAVES * 64, 2) mk_fwd(Args args) {
    extern __shared__ __attribute__((aligned(16))) unsigned char lds[];
    Frame F;
    F.lds = (LAS unsigned char*)lds;
    F.MISC = (volatile LAS unsigned*)(F.lds + MISC_OFF);
    F.tid = threadIdx.x; F.lane = F.tid & 63; F.wave = __builtin_amdgcn_readfirstlane(F.tid >> 6);
    F.G = gridDim.x; { const int bx = blockIdx.x; F.vcu = (F.G % 8 == 0) ? (bx % 8) * (F.G / 8) + bx / 8 : bx; }
    unsigned char* ws = args.ws;
    F.ctl = (gu32*)(ws + WS_CTL);
    F.xp = args.in[0]; F.xs = args.in[1]; F.ck = args.in[2]; F.cv = args.in[3]; F.sconv = args.in[4]; F.norm_g = args.in[5]; F.w_in = args.in[6]; F.conv_w = args.in[7]; F.w_out = args.in[8]; F.final_g = args.in[9];
    F.out = args.out;
    F.Win_t = (bf16*)(ws + WS_WIN); F.Wout_t = (bf16*)(ws + WS_WOUT); F.H = (bf16*)(ws + WS_H); F.Qb = (bf16*)(ws + WS_Q); F.Kb = (bf16*)(ws + WS_K); F.Vb = (bf16*)(ws + WS_V);
    F.Gs = (bf16*)(ws + WS_GS); F.CU = (bf16*)(ws + WS_CU); F.BG = (bf16*)(ws + WS_BG); F.MIX = (bf16*)(ws + WS_MIX);
    for (int u = F.tid; u < (LDS_BYTES - LDSCTL_OFF) / 4; u += NWAVES * 64) ((LAS unsigned*)(F.lds + LDSCTL_OFF))[u] = 0u;
    __syncthreads();
    const int pm = args.ph_mask;
    const bool multi = (pm & (pm - 1)) != 0 && pm != 12;
    XcdBarrier bar; bar.bar = (unsigned*)(F.ctl + 4096); bar.x = 0; bar.st = nullptr;
    if (multi) bar = xcd_barrier_post((unsigned*)(F.ctl + 4096), F.MISC + 8);
#define SEAM(rest) do { if (multi && (pm & (rest))) xcd_barrier(bar); } while (0)

    if (pm & 1) { p0_prologue(F); SEAM(62); }
    if (pm & 2) {
        pg8::Gemm g{F.H, F.Win_t, MT, DIN, DM}; pg8::StaticOrder S; S.init(MT, DIN, F.G, (int)blockIdx.x);
        pg8::Epi1 E{F.Qb, F.Kb, F.Vb, F.Gs, F.CU, F.BG, F.out};
        pg8::gemm_phase<pg8::Epi1, pg8::StaticOrder, true, true>(F.lds + RING_OFF, g, S, E);
        SEAM(60);
    }
    if (pm & 4) { const sb::Ctx C{F.Qb, F.Kb, F.Vb, F.Gs, F.MIX, F.ck, F.cv}; sb::attn_phase<SB_EARLY>(F.lds, C, F.vcu, F.G, F.wave, F.lane); }
    if (pm & 8) { p2_convmix(F); }
    if (pm & 12) { SEAM(48); }
    if (pm & 16) {
        pg8::Gemm g{F.MIX, F.Wout_t, MT, DM, DM}; pg8::StaticOrder S; S.init(MT, DM, F.G, (int)blockIdx.x);
        pg8::Epi2 E{F.xp, F.xs, F.out + O_Y};
        pg8::gemm_phase<pg8::Epi2, pg8::StaticOrder, true, true>(F.lds + RING_OFF, g, S, E);
        SEAM(32);
    }
    if (pm & 32) { p4_final_norm(F); }
#undef SEAM
}

#ifndef NAIVE_P1
#define NAIVE_P1 0
#endif
#ifndef NAIVE_P2
#define NAIVE_P2 0
#endif
#ifndef NAIVE_P3
#define NAIVE_P3 0
#endif
#ifndef ONE_LAUNCH
#define ONE_LAUNCH 1
#endif
#if NAIVE_P1 || NAIVE_P3
__global__ void __launch_bounds__(256) gemm_naive(const bf16* A, const bf16* Bt, float* C, int M, int N, int K) {
    __shared__ float As[32][65], Bs[32][65];
    const int t = threadIdx.x, tx = t & 15, ty = t >> 4, m0 = blockIdx.y * 64, n0 = blockIdx.x * 64;
    float acc[4][4];
#pragma unroll
    for (int i = 0; i < 4; ++i)
#pragma unroll
        for (int j = 0; j < 4; ++j) acc[i][j] = 0.f;
    for (int k0 = 0; k0 < K; k0 += 32) {
        { const v4u a = *(const v4u*)(A + (size_t)(m0 + (t >> 2)) * K + k0 + (t & 3) * 8); float f[8]; unpack8(a, f);
#pragma unroll
          for (int j = 0; j < 8; ++j) As[(t & 3) * 8 + j][t >> 2] = f[j]; }
        { const v4u a = *(const v4u*)(Bt + (size_t)(n0 + (t >> 2)) * K + k0 + (t & 3) * 8); float f[8]; unpack8(a, f);
#pragma unroll
          for (int j = 0; j < 8; ++j) Bs[(t & 3) * 8 + j][t >> 2] = f[j]; }
        __syncthreads();
#pragma unroll 8
        for (int kk = 0; kk < 32; ++kk) { float a[4], b[4];
#pragma unroll
            for (int i = 0; i < 4; ++i) { a[i] = As[kk][ty * 4 + i]; b[i] = Bs[kk][tx * 4 + i]; }
#pragma unroll
            for (int i = 0; i < 4; ++i)
#pragma unroll
                for (int j = 0; j < 4; ++j) acc[i][j] += a[i] * b[j]; }
        __syncthreads();
    }
#pragma unroll
    for (int i = 0; i < 4; ++i)
#pragma unroll
        for (int j = 0; j < 4; ++j) C[(size_t)(m0 + ty * 4 + i) * N + n0 + tx * 4 + j] = acc[i][j];
}
#endif
#if NAIVE_P1
__device__ __forceinline__ unsigned short f2bf1(float f) { return (unsigned short)(cvtpk(f, 0.f) & 0xffffu); }
__global__ void __launch_bounds__(256) epi1_naive(const float* C, bf16* Qb, bf16* Kb, bf16* Vb, bf16* Gs, bf16* CU, bf16* BG, float* out) {
    const size_t gid = (size_t)blockIdx.x * 256 + threadIdx.x; if (gid >= (size_t)MT * 32 * 128) return;
    const int cc = (int)(gid & 127), pn = (int)((gid >> 7) & 31), row = (int)(gid >> 12);
    const float v0 = C[(size_t)row * DIN + 256 * pn + cc], v1 = C[(size_t)row * DIN + 256 * pn + 128 + cc];
    if (pn < 16) {
        const int typ = pn >> 2;
        for (int k = 0; k < 2; ++k) { const int col = (pn & 3) * 256 + cc + 128 * k; float v = k ? v1 : v0;
            if (typ == 0) Qb[(size_t)row * DH + col] = f2bf1(v * C2);
            else if (typ == 3) Gs[(size_t)row * DH + col] = f2bf1(v / (1.f + expf(-v)));
            else { (typ == 1 ? Kb : Vb)[(size_t)row * DH + col] = f2bf1(v);
                   out[(row < MP ? (typ == 1 ? O_KP : O_VP) + (size_t)row * DH : (typ == 1 ? O_KS : O_VS) + (size_t)(row - MP) * DH) + col] = v; } }
    } else if (pn < 24) {
        const int ch = (pn - 16) * 128 + cc; const float cu = v0 * v1; CU[(size_t)row * DH + ch] = f2bf1(cu);
        if (row < MP) { const int t = row & (SEQ - 1); if (t >= SEQ - 2) out[O_CP + (size_t)((row >> 11) * 2 + (t - (SEQ - 2))) * DH + ch] = cu; }
        else { const int r2 = row - MP, t = r2 & (DS - 1); if (t >= DS - 2) out[O_CS + (size_t)((r2 >> 5) * 2 + (t - (DS - 2))) * DH + ch] = cu; }
    } else { const int ch = (pn - 24) * 128 + cc; BG[(size_t)row * DH + ch] = f2bf1(v0 * (v1 / (1.f + expf(-v1)))); }
}
#endif
#if NAIVE_P3
__global__ void __launch_bounds__(256) epi2_naive(const float* C, const float* xp, const float* xs, float* y) {
    const size_t gid = (size_t)blockIdx.x * 256 + threadIdx.x; if (gid >= (size_t)MT * DM) return;
    const size_t row = gid / DM, col = gid % DM; const float x = row < MP ? xp[row * DM + col] : xs[(row - MP) * DM + col];
    y[gid] = x + C[gid];
}
#endif
#if NAIVE_P2
__global__ void __launch_bounds__(256) attn_naive(const bf16* Qb, const bf16* Kb, const bf16* Vb, const bf16* Gs, const float* ck, const float* cv, bf16* MIX) {
    const int gw = blockIdx.x * 4 + (threadIdx.x >> 6), lane = threadIdx.x & 63; if (gw >= MT * NH) return;
    const int row = gw >> 3, h = gw & 7, d = 2 * lane;
    const float q0 = bf2f(Qb[(size_t)row * DH + h * HD + d]), q1 = bf2f(Qb[(size_t)row * DH + h * HD + d + 1]);
    float run = 0.f, o0 = 0.f, o1 = 0.f;
    int nnew, krow0, ncache = 0, b;
    if (row < MP) { b = row >> 11; nnew = row & (SEQ - 1); krow0 = b * SEQ; } else { const int r2 = row - MP; b = r2 >> 5; nnew = r2 & (DS - 1); krow0 = MP + b * DS; ncache = PAST; }
    for (int j = nnew - 1; j >= 0; --j) {
        const size_t kr = (size_t)(krow0 + j) * DH + h * HD + d;
        float p = q0 * bf2f(Kb[kr]) + q1 * bf2f(Kb[kr + 1]);
#pragma unroll
        for (int s = 1; s < 64; s <<= 1) p += __shfl_xor(p, s);
        const float z = p, e = exp2f(-fabsf(z)), lp = log2f(1.f + e), lb = fminf(z, 0.f) - lp, l1 = fminf(-z, 0.f) - lp, w = exp2f(lb + run);
        o0 += w * bf2f(Vb[kr]); o1 += w * bf2f(Vb[kr + 1]); run += l1;
    }
    for (int j = ncache - 1; j >= 0; --j) {
        const size_t kr = ((size_t)b * PAST + j) * DH + h * HD + d;
        float p = q0 * ck[kr] + q1 * ck[kr + 1];
#pragma unroll
        for (int s = 1; s < 64; s <<= 1) p += __shfl_xor(p, s);
        const float z = p, e = exp2f(-fabsf(z)), lp = log2f(1.f + e), lb = fminf(z, 0.f) - lp, l1 = fminf(-z, 0.f) - lp, w = exp2f(lb + run);
        o0 += w * cv[kr]; o1 += w * cv[kr + 1]; run += l1;
    }
    const size_t gi = (size_t)row * DH + h * HD + d;
    const unsigned w = cvtpk(o0 * bf2f(Gs[gi]), o1 * bf2f(Gs[gi + 1]));
    *(unsigned*)(MIX + (size_t)row * DM + h * HD + d) = w;
}
#endif

extern "C" void kernel_launch(void* const* d_in, const int* in_sizes, int n_in, void* d_out, int out_size, void* d_ws, size_t ws_size, hipStream_t stream) {
    static int grid = 0;
    if (grid == 0) {
        if (n_in != 10 || (size_t)out_size != O_END || ws_size < 512 * MiB) { fprintf(stderr, "kernel_launch: unexpected sizes: n_in %d out %d ws %zu; nothing launched\n", n_in, out_size, ws_size); grid = -1; return; }
        int dev = 0, cus = 0, per_cu = 0;
        if (hipGetDevice(&dev) != hipSuccess || hipDeviceGetAttribute(&cus, hipDeviceAttributeMultiprocessorCount, dev) != hipSuccess) { grid = -1; return; }
        if (hipFuncSetAttribute((const void*)mk_fwd, hipFuncAttributeMaxDynamicSharedMemorySize, LDS_BYTES) != hipSuccess) { fprintf(stderr, "kernel_launch: hipFuncSetAttribute failed\n"); grid = -1; return; }
        if (hipOccupancyMaxActiveBlocksPerMultiprocessor(&per_cu, (const void*)mk_fwd, NWAVES * 64, LDS_BYTES) != hipSuccess || per_cu < 1) { fprintf(stderr, "kernel_launch: occupancy query says %d blocks per CU\n", per_cu); grid = -1; (void)hipGetLastError(); return; }
        grid = cus;
    }
    if (grid < 0) return;
    (void)hipMemsetAsync((char*)d_ws + WS_CTL, 0, CTL_ZERO_BYTES, stream);
    Args a{};
    for (int i = 0; i < 10; ++i) a.in[i] = (const float*)d_in[i];
    a.out = (float*)d_out; a.ws = (unsigned char*)d_ws;
    unsigned char* ws = (unsigned char*)d_ws;
#if ONE_LAUNCH
    a.ph_mask = 63;
    void* kargs[] = {&a};
    hipError_t e = hipLaunchCooperativeKernel((const void*)mk_fwd, dim3(grid), dim3(NWAVES * 64), kargs, LDS_BYTES, stream);
    if (e != hipSuccess) fprintf(stderr, "kernel_launch: cooperative launch failed: %s (grid %d)\n", hipGetErrorString(e), grid);
#else
#define LAUNCH_PH(mask) do { a.ph_mask = (mask); hipLaunchKernelGGL(mk_fwd, dim3(grid), dim3(NWAVES * 64), LDS_BYTES, stream, a); } while (0)
    LAUNCH_PH(1);
#if NAIVE_P1
    gemm_naive<<<dim3(DIN / 64, MT / 64), 256, 0, stream>>>((const bf16*)(ws + WS_H), (const bf16*)(ws + WS_WIN), (float*)(ws + WS_TMP), MT, DIN, DM);
    epi1_naive<<<(unsigned)(((size_t)MT * 32 * 128 + 255) / 256), 256, 0, stream>>>((const float*)(ws + WS_TMP), (bf16*)(ws + WS_Q), (bf16*)(ws + WS_K), (bf16*)(ws + WS_V), (bf16*)(ws + WS_GS), (bf16*)(ws + WS_CU), (bf16*)(ws + WS_BG), (float*)d_out);
#else
    LAUNCH_PH(2);
#endif
#if NAIVE_P2
    attn_naive<<<MT * NH / 4, 256, 0, stream>>>((const bf16*)(ws + WS_Q), (const bf16*)(ws + WS_K), (const bf16*)(ws + WS_V), (const bf16*)(ws + WS_GS), (const float*)d_in[2], (const float*)d_in[3], (bf16*)(ws + WS_MIX));
    LAUNCH_PH(8);
#else
    LAUNCH_PH(12);
#endif
#if NAIVE_P3
    gemm_naive<<<dim3(DM / 64, MT / 64), 256, 0, stream>>>((const bf16*)(ws + WS_MIX), (const bf16*)(ws + WS_WOUT), (float*)(ws + WS_TMP), MT, DM, DM);
    epi2_naive<<<(unsigned)(((size_t)MT * DM + 255) / 256), 256, 0, stream>>>((const float*)(ws + WS_TMP), (const float*)d_in[0], (const float*)d_in[1], (float*)d_out + O_Y);
#else
    LAUNCH_PH(16);
#endif
    LAUNCH_PH(32);
#endif
    (void)ws;
}
```

```cpp
#include <hip/hip_runtime.h>
#include <cstdio>
#include <cstdint>

constexpr int DM = 2048;
constexpr int NB = 4, SEQ = 2048;
constexpr int DB = 32, DS = 32, PAST = 1024;
constexpr int MP = NB * SEQ;
constexpr int MS = DB * DS;
constexpr int MT = MP + MS;
constexpr int DIN = 8192;
constexpr int DH = 1024;
constexpr int NH = 8, HD = 128;
constexpr float EPS = 1e-6f;
constexpr float C2 = 0.08838834764831845f * 1.4426950408889634f;

constexpr size_t O_Y = 0;
constexpr size_t O_KP = (size_t)MT * DM;
constexpr size_t O_VP = O_KP + (size_t)MP * DH;
constexpr size_t O_CP = O_VP + (size_t)MP * DH;
constexpr size_t O_KS = O_CP + (size_t)NB * 2 * DH;
constexpr size_t O_VS = O_KS + (size_t)MS * DH;
constexpr size_t O_CS = O_VS + (size_t)MS * DH;
constexpr size_t O_END = O_CS + (size_t)DB * 2 * DH;

constexpr size_t MiB = 1u << 20;
constexpr size_t WS_CTL = 0, CTL_ZERO_BYTES = 1 * MiB;
constexpr size_t WS_WIN = 2 * MiB;
constexpr size_t WS_WOUT = 34 * MiB;
constexpr size_t WS_H = 42 * MiB;
constexpr size_t WS_Q = 78 * MiB, WS_K = 96 * MiB, WS_V = 114 * MiB, WS_GS = 132 * MiB, WS_CU = 150 * MiB, WS_BG = 168 * MiB;
constexpr size_t WS_MIX = 186 * MiB;
constexpr size_t WS_TMP = 224 * MiB;
constexpr size_t WS_END = 222 * MiB;

typedef unsigned short bf16;
#define GAS __attribute__((address_space(1)))
#define LAS __attribute__((address_space(3)))
#define NAIVE_P1 0
#define NAIVE_P2 0
#define NAIVE_P3 0
#define ONE_LAUNCH 1
namespace pg8 {
#define PG8_LAS __attribute__((address_space(3)))
typedef unsigned short bf16_t;
typedef short bf16x8 __attribute__((ext_vector_type(8)));
typedef float f32x4 __attribute__((ext_vector_type(4)));
typedef unsigned u32x4 __attribute__((ext_vector_type(4)));
constexpr int BM = 256, BK = 64, HALF = 128, HTB = HALF * BK * 2  , STAGE_BYTES = 8 * HTB, NXCD = 8, WGM = 8;

__host__ __device__ __forceinline__ int lds_byte(int r, int c) { const int st = (r >> 4) * 2 + (c >> 5), rr = r & 15, cc = c & 31, ob = rr * 64 + cc * 2; return st * 1024 + (ob ^ (((ob >> 9) & 1) << 5)); }
__host__ __device__ __forceinline__ void stage_rc(int b, int& R, int& C) { const int st = b / 1024, sb = b % 1024, swz = sb ^ (((sb >> 9) & 1) << 5); R = (st >> 1) * 16 + swz / 64; C = (st & 1) * 32 + (swz % 64) / 2; }
__host__ __device__ __forceinline__ int perm32(int rho) { const int n = rho >> 4, i = rho & 15; return 8 * (i >> 2) + 4 * n + (i & 3); }

struct Unit { int pm, pn; };
struct Gemm { const bf16_t* A; const bf16_t* Bt; int M, N, K; };

struct StaticOrder {
    int nM, nN, nwg, G, c;
    __host__ __device__ void init(int M, int N, int G_, int c_) { nM = M / BM; nN = N / BM; nwg = nM * nN; G = G_; c = c_; }
    __host__ __device__ bool next(int i, Unit& u) const {
        const long L = (long)i * G + c; if (L >= nwg) return false;
        int wgid = (int)L; { const int q = nwg / NXCD, r = nwg % NXCD, xcd = wgid % NXCD, off = wgid / NXCD; wgid = (xcd < r ? xcd * (q + 1) : r * (q + 1) + (xcd - r) * q) + off; }
        const int nig = WGM * nN, gid = wgid / nig, fm = gid * WGM, gsz = (nM - fm) < WGM ? (nM - fm) : WGM;
        u.pm = fm + ((wgid % nig) % gsz); u.pn = (wgid % nig) / gsz; return true;
    }
    __device__ __forceinline__ void a_ready(const Unit&) const {}
    __device__ __forceinline__ void done(const Unit&) const {}
};

typedef float f32x2_t __attribute__((ext_vector_type(2))); typedef __bf16 bf16x2_t __attribute__((ext_vector_type(2)));
__device__ __forceinline__ unsigned cvtpk(float lo, float hi) { f32x2_t v = {lo, hi}; bf16x2_t b = __builtin_convertvector(v, bf16x2_t); return __builtin_bit_cast(unsigned, b); }
__device__ __forceinline__ float silu_f(float x) { return x * __builtin_amdgcn_rcpf(1.0f + __builtin_amdgcn_exp2f(-1.4426950408889634f * x)); }
__device__ __forceinline__ f32x4 silu4(f32x4 v) { f32x4 o; o[0] = silu_f(v[0]); o[1] = silu_f(v[1]); o[2] = silu_f(v[2]); o[3] = silu_f(v[3]); return o; }

struct Epi1 {
    static constexpr bool PERM = true, AFTER_DRAIN = false;
    bf16_t *Qb, *Kb, *Vb, *Gs, *CU, *BG; float* out;
    __device__ __forceinline__ void operator()(const f32x4 (&acc)[2][2][4][2], const Unit& u, int wr, int wc, int fr, int fq) const {
        const int pn = u.pn, row0 = u.pm * BM + wr * 64 + fr, cl = wc * 32 + 8 * fq;
        if (pn < 16) {
            const int typ = pn >> 2, colb = (pn & 3) * 256 + cl;
            bf16_t* dst = typ == 0 ? Qb : (typ == 1 ? Kb : (typ == 2 ? Vb : Gs));
#pragma unroll
            for (int ai = 0; ai < 2; ++ai)
#pragma unroll
                for (int m = 0; m < 4; ++m) { const int row = row0 + ai * HALF + m * 16;
#pragma unroll
                    for (int bj = 0; bj < 2; ++bj) { const int col = colb + bj * HALF; f32x4 v0 = acc[ai][bj][m][0], v1 = acc[ai][bj][m][1];
                        if (typ == 0) { v0 = v0 * C2; v1 = v1 * C2; }
                        if (typ == 3) { v0 = silu4(v0); v1 = silu4(v1); }
                        if (typ == 1 || typ == 2) {
                            float* o = out + (row < MP ? (typ == 1 ? O_KP : O_VP) + (size_t)row * DH : (typ == 1 ? O_KS : O_VS) + (size_t)(row - MP) * DH) + col;
                            *(f32x4*)o = v0; *(f32x4*)(o + 4) = v1; }
                        u32x4 w; w.x = cvtpk(v0[0], v0[1]); w.y = cvtpk(v0[2], v0[3]); w.z = cvtpk(v1[0], v1[1]); w.w = cvtpk(v1[2], v1[3]);
                        *(u32x4*)(dst + (size_t)row * DH + col) = w; } }
        } else if (pn < 24) {
            const int chb = (pn - 16) * 128 + cl;
#pragma unroll
            for (int ai = 0; ai < 2; ++ai)
#pragma unroll
                for (int m = 0; m < 4; ++m) { const int row = row0 + ai * HALF + m * 16;
                    const f32x4 v0 = acc[ai][0][m][0] * acc[ai][1][m][0], v1 = acc[ai][0][m][1] * acc[ai][1][m][1];
                    u32x4 w; w.x = cvtpk(v0[0], v0[1]); w.y = cvtpk(v0[2], v0[3]); w.z = cvtpk(v1[0], v1[1]); w.w = cvtpk(v1[2], v1[3]);
                    *(u32x4*)(CU + (size_t)row * DH + chb) = w;
                    if (row < MP) { const int t = row & (SEQ - 1); if (t >= SEQ - 2) { float* o = out + O_CP + (size_t)((row >> 11) * 2 + (t - (SEQ - 2))) * DH + chb; *(f32x4*)o = v0; *(f32x4*)(o + 4) = v1; } }
                    else { const int r2 = row - MP, t = r2 & (DS - 1); if (t >= DS - 2) { float* o = out + O_CS + (size_t)((r2 >> 5) * 2 + (t - (DS - 2))) * DH + chb; *(f32x4*)o = v0; *(f32x4*)(o + 4) = v1; } } }
        } else {
            const int chb = (pn - 24) * 128 + cl;
#pragma unroll
            for (int ai = 0; ai < 2; ++ai)
#pragma unroll
                for (int m = 0; m < 4; ++m) { const int row = row0 + ai * HALF + m * 16;
                    const f32x4 v0 = acc[ai][0][m][0] * silu4(acc[ai][1][m][0]), v1 = acc[ai][0][m][1] * silu4(acc[ai][1][m][1]);
                    u32x4 w; w.x = cvtpk(v0[0], v0[1]); w.y = cvtpk(v0[2], v0[3]); w.z = cvtpk(v1[0], v1[1]); w.w = cvtpk(v1[2], v1[3]);
                    *(u32x4*)(BG + (size_t)row * DH + chb) = w; }
        }
    }
};
struct Epi2 {
    static constexpr bool PERM = false, AFTER_DRAIN = false;
    const float* xp; const float* xs; float* y;
    __device__ __forceinline__ void operator()(const f32x4 (&acc)[2][2][4][2], const Unit& u, int wr, int wc, int fr, int fq) const {
        const int row0 = u.pm * BM + wr * 64 + fr, col0 = u.pn * BM + wc * 32 + 4 * fq;
#pragma unroll
        for (int ai = 0; ai < 2; ++ai)
#pragma unroll
            for (int m = 0; m < 4; ++m) { const int row = row0 + ai * HALF + m * 16;
                const float* xr = row < MP ? xp + (size_t)row * DM : xs + (size_t)(row - MP) * DM; float* yr = y + (size_t)row * DM;
#pragma unroll
                for (int bj = 0; bj < 2; ++bj)
#pragma unroll
                    for (int n = 0; n < 2; ++n) { const int col = col0 + bj * HALF + n * 16; *(f32x4*)(yr + col) = acc[ai][bj][m][n] + *(const f32x4*)(xr + col); } }
    }
};

template <class Epi, class Sched, bool ALIGN_EPI = false, bool SP2 = false>
__device__ __forceinline__ void gemm_phase(PG8_LAS unsigned char* lds, const Gemm g, const Sched& S, const Epi& E) {
    const int tid = threadIdx.x, wid = __builtin_amdgcn_readfirstlane(tid >> 6), lane = tid & 63, wr = wid >> 2, wc = wid & 3, fr = lane & 15, fq = lane >> 4;
    const int K = g.K, nt = K / BK;
    unsigned voffA[2], voffB[2];
#pragma unroll
    for (int i = 0; i < 2; ++i) { int R, C; stage_rc(tid * 16 + i * 8192, R, C); const int Rb = Epi::PERM ? ((R & ~31) + perm32(R & 31)) : R;
        voffA[i] = (unsigned)(R * K + C) * 2u; voffB[i] = (unsigned)(Rb * K + C) * 2u; }
    const size_t kstep = (size_t)(BK * 2);
    const size_t hstep = (size_t)HALF * K * 2;
    const size_t tstep = 2 * hstep;
    const unsigned ldsw = (unsigned)wid * 1024u;
    const int aoff = lds_byte(wr * 64 + fr, fq * 8), boff = lds_byte(wc * 32 + fr, fq * 8);
#define PG8_SA(b, h) (((b) * 2 + (h)) * HTB)
#define PG8_SB(b, h) ((4 + (b) * 2 + (h)) * HTB)
#define PG8_STAGE(bufoff, gbase, voff) do { _Pragma("unroll") for (int _i = 0; _i < 2; ++_i) \
        __builtin_amdgcn_global_load_lds((const unsigned*)((const char*)(gbase) + (voff)[_i]), (PG8_LAS unsigned*)(lds + (bufoff) + ldsw + _i * 8192), 16, 0, 0); } while (0)
#define PG8_LDA(dst, b, h) do { _Pragma("unroll") for (int m = 0; m < 4; ++m) _Pragma("unroll") for (int k = 0; k < 2; ++k) dst[m][k] = *(const PG8_LAS bf16x8*)(lds + PG8_SA(b, h) + aoff + m * 2048 + k * 1024); } while (0)
#define PG8_LDB(dst, b, h) do { _Pragma("unroll") for (int n = 0; n < 2; ++n) _Pragma("unroll") for (int k = 0; k < 2; ++k) dst[n][k] = *(const PG8_LAS bf16x8*)(lds + PG8_SB(b, h) + boff + n * 2048 + k * 1024); } while (0)
#define PG8_MMA(ai, bj, At, Bt) do { __builtin_amdgcn_s_setprio(1); _Pragma("unroll") for (int m = 0; m < 4; ++m) _Pragma("unroll") for (int n = 0; n < 2; ++n) _Pragma("unroll") for (int k = 0; k < 2; ++k) \
        acc[ai][bj][m][n] = __builtin_amdgcn_mfma_f32_16x16x32_bf16(Bt[n][k], At[m][k], acc[ai][bj][m][n], 0, 0, 0); __builtin_amdgcn_s_setprio(0); } while (0)
#define PG8_WAIT_V(n) asm volatile("s_waitcnt vmcnt(" #n ")" ::: "memory")
#define PG8_WAIT_L(n) asm volatile("s_waitcnt lgkmcnt(" #n ")" ::: "memory")
#define PG8_BAR __builtin_amdgcn_s_barrier()
#define PG8_SCHED __builtin_amdgcn_sched_barrier(0)
    Unit cur, nxt; int ui = 0;
    if (!S.next(0, cur)) return;
    f32x4 acc[2][2][4][2];
#pragma unroll
    for (int a = 0; a < 2; ++a)
#pragma unroll
        for (int b = 0; b < 2; ++b)
#pragma unroll
            for (int m = 0; m < 4; ++m)
#pragma unroll
                for (int n = 0; n < 2; ++n) acc[a][b][m][n] = (f32x4){0.f, 0.f, 0.f, 0.f};
    bf16x8 At[4][2], B0[2][2], B1[2][2];
    const char* cA = (const char*)g.A + (size_t)cur.pm * tstep; const char* cB = (const char*)g.Bt + (size_t)cur.pn * tstep;
    S.a_ready(cur);
    if constexpr (SP2) {
        PG8_STAGE(PG8_SB(0, 0), cB, voffB); PG8_STAGE(PG8_SB(0, 1), cB + hstep, voffB); PG8_STAGE(PG8_SA(0, 0), cA, voffA); PG8_STAGE(PG8_SA(0, 1), cA + hstep, voffA);
        if (wr == 1) PG8_BAR;
        PG8_WAIT_V(2); PG8_BAR;
        PG8_STAGE(PG8_SB(1, 0), cB + kstep, voffB); PG8_STAGE(PG8_SA(1, 0), cA + kstep, voffA); PG8_STAGE(PG8_SB(1, 1), cB + hstep + kstep, voffB);
        PG8_WAIT_V(6); PG8_BAR;
    } else {
        PG8_STAGE(PG8_SB(0, 0), cB, voffB); PG8_STAGE(PG8_SA(0, 0), cA, voffA); PG8_STAGE(PG8_SB(0, 1), cB + hstep, voffB); PG8_STAGE(PG8_SA(0, 1), cA + hstep, voffA);
        if (wr == 1) PG8_BAR;
        PG8_WAIT_V(4); PG8_BAR;
        PG8_STAGE(PG8_SB(1, 0), cB + kstep, voffB); PG8_STAGE(PG8_SA(1, 0), cA + kstep, voffA); PG8_STAGE(PG8_SB(1, 1), cB + hstep + kstep, voffB);
        PG8_WAIT_V(6); PG8_BAR;
    }
    for (;;) {
        const bool has_next = S.next(ui + 1, nxt);
        const char* nA = has_next ? (const char*)g.A + (size_t)nxt.pm * tstep : cA; const char* nB = has_next ? (const char*)g.Bt + (size_t)nxt.pn * tstep : cB;
        for (int t = 0; t < nt; t += 2) {
            const bool last = (t == nt - 2);
            const char* a1 = cA + (size_t)(t + 1) * kstep;
            const char* a2 = last ? nA : cA + (size_t)(t + 2) * kstep; const char* b2 = last ? nB : cB + (size_t)(t + 2) * kstep;
            const char* a3 = a2 + kstep; const char* b3 = b2 + kstep;
            if (last && has_next) S.a_ready(nxt);
            if constexpr (SP2) {
            PG8_LDB(B0, 0, 0); PG8_LDB(B1, 0, 1); PG8_SCHED; PG8_LDA(At, 0, 0); PG8_STAGE(PG8_SA(1, 1), a1 + hstep, voffA);
            PG8_WAIT_V(8); PG8_WAIT_L(0); PG8_BAR; PG8_MMA(0, 0, At, B0); PG8_MMA(0, 1, At, B1); PG8_BAR; PG8_SCHED;
            PG8_LDA(At, 0, 1); PG8_STAGE(PG8_SB(0, 0), b2, voffB); PG8_STAGE(PG8_SB(0, 1), b2 + hstep, voffB); PG8_STAGE(PG8_SA(0, 0), a2, voffA);
            PG8_WAIT_V(8); PG8_WAIT_L(0); PG8_BAR; PG8_MMA(1, 0, At, B0); PG8_MMA(1, 1, At, B1); PG8_BAR; PG8_SCHED;
            PG8_LDB(B0, 1, 0); PG8_LDB(B1, 1, 1); PG8_SCHED; PG8_LDA(At, 1, 0); PG8_STAGE(PG8_SA(0, 1), a2 + hstep, voffA);
            PG8_WAIT_V(8); PG8_WAIT_L(0); PG8_BAR; PG8_MMA(0, 0, At, B0); PG8_MMA(0, 1, At, B1); PG8_BAR; PG8_SCHED;
            PG8_LDA(At, 1, 1); PG8_STAGE(PG8_SB(1, 0), b3, voffB); PG8_STAGE(PG8_SB(1, 1), b3 + hstep, voffB); PG8_STAGE(PG8_SA(1, 0), a3, voffA);
            PG8_WAIT_V(8); PG8_WAIT_L(0); PG8_BAR; PG8_MMA(1, 0, At, B0); PG8_MMA(1, 1, At, B1); PG8_BAR; PG8_SCHED;
            } else {
            PG8_LDB(B0, 0, 0); PG8_SCHED; PG8_LDA(At, 0, 0); PG8_STAGE(PG8_SA(1, 1), a1 + hstep, voffA);
            PG8_WAIT_L(8); PG8_BAR; PG8_WAIT_L(0); PG8_MMA(0, 0, At, B0); PG8_BAR; PG8_SCHED;
            PG8_LDB(B1, 0, 1); PG8_STAGE(PG8_SB(0, 0), b2, voffB);
            PG8_BAR; PG8_WAIT_L(0); PG8_MMA(0, 1, At, B1); PG8_BAR;
            PG8_LDA(At, 0, 1); PG8_STAGE(PG8_SA(0, 0), a2, voffA);
            PG8_BAR; PG8_WAIT_L(0); PG8_MMA(1, 0, At, B0); PG8_BAR; PG8_SCHED;
            PG8_STAGE(PG8_SB(0, 1), b2 + hstep, voffB);
            PG8_WAIT_V(6); PG8_BAR; PG8_MMA(1, 1, At, B1); PG8_BAR;
            PG8_LDB(B0, 1, 0); PG8_SCHED; PG8_LDA(At, 1, 0); PG8_STAGE(PG8_SA(0, 1), a2 + hstep, voffA);
            PG8_WAIT_L(8); PG8_BAR; PG8_WAIT_L(0); PG8_MMA(0, 0, At, B0); PG8_BAR; PG8_SCHED;
            PG8_LDB(B1, 1, 1); PG8_STAGE(PG8_SB(1, 0), b3, voffB);
            PG8_BAR; PG8_WAIT_L(0); PG8_MMA(0, 1, At, B1); PG8_BAR;
            PG8_LDA(At, 1, 1); PG8_STAGE(PG8_SA(1, 0), a3, voffA);
            PG8_BAR; PG8_WAIT_L(0); PG8_MMA(1, 0, At, B0); PG8_BAR; PG8_SCHED;
            PG8_STAGE(PG8_SB(1, 1), b3 + hstep, voffB);
            PG8_WAIT_V(6); PG8_BAR; PG8_MMA(1, 1, At, B1); PG8_BAR;
            }
        }
        if constexpr (ALIGN_EPI) { if (wr == 0) PG8_BAR; }
        if constexpr (!Epi::AFTER_DRAIN) { E(acc, cur, wr, wc, fr, fq); S.done(cur); }
        if (!has_next) break;
#pragma unroll
        for (int a = 0; a < 2; ++a)
#pragma unroll
            for (int b = 0; b < 2; ++b)
#pragma unroll
                for (int m = 0; m < 4; ++m)
#pragma unroll
                    for (int n = 0; n < 2; ++n) acc[a][b][m][n] = (f32x4){0.f, 0.f, 0.f, 0.f};
        cur = nxt; cA = nA; cB = nB; ++ui;
        if constexpr (ALIGN_EPI) { if (wr == 1) PG8_BAR; }
    }
    PG8_WAIT_V(0);
    if constexpr (!ALIGN_EPI) { if (wr == 0) PG8_BAR; }
    PG8_BAR;
    if constexpr (Epi::AFTER_DRAIN) { E.fused(acc, cur, wr, wc, fr, fq, lds, wid, lane); S.done(cur); }
#undef PG8_SA
#undef PG8_SB
#undef PG8_STAGE
#undef PG8_LDA
#undef PG8_LDB
#undef PG8_MMA
#undef PG8_WAIT_V
#undef PG8_WAIT_L
#undef PG8_BAR
#undef PG8_SCHED
}
}
constexpr int NWAVES = 8;
constexpr int RING_OFF = 0, RING_BYTES = 131072;
constexpr int LDSCTL_OFF = 155648, MISC_OFF = LDSCTL_OFF + 320;
constexpr int XCH_OFF = LDSCTL_OFF + 1024;
constexpr int LDS_BYTES = 159744;
static_assert(XCH_OFF + 1024 <= LDS_BYTES && MISC_OFF + 128 <= XCH_OFF, "LDS map");

typedef unsigned v4u __attribute__((ext_vector_type(4)));
typedef unsigned v2u __attribute__((ext_vector_type(2)));
typedef float f32x4 __attribute__((ext_vector_type(4)));
typedef short bf16x8 __attribute__((ext_vector_type(8)));
typedef short s16x4 __attribute__((ext_vector_type(4)));
typedef float f32x16 __attribute__((ext_vector_type(16)));
typedef GAS unsigned gu32;
#define RLX_AGENT __ATOMIC_RELAXED, __HIP_MEMORY_SCOPE_AGENT
#define LDS_WAIT() asm volatile("s_waitcnt lgkmcnt(0)" ::: "memory")
#define VM_WAIT() asm volatile("s_waitcnt vmcnt(0)" ::: "memory")
#define CFENCE() do { asm volatile("" ::: "memory"); __builtin_amdgcn_wave_barrier(); asm volatile("" ::: "memory"); } while (0)
using pg8::cvtpk;
__device__ __forceinline__ float bf2f(unsigned b) { return __uint_as_float(b << 16); }
__device__ __forceinline__ float bflo(unsigned w) { return __uint_as_float(w << 16); }
__device__ __forceinline__ float bfhi(unsigned w) { return __uint_as_float(w & 0xffff0000u); }

#define XB_TMO      128
#define XB_XCNT(j)  (256  + 64 * (j))
#define XB_XSUB(j)  (1280 + 64 * (j))
#define XB_XGEN(j)  (2304 + 64 * (j))
#define XB_TOP      3328
#define XB_TOPGEN   3392
#define XCD_BAR_WORDS 3456
#define XB_SPIN_CAP (1u << 18)

__device__ __forceinline__ unsigned xb_ld(unsigned* p)              { return __hip_atomic_load(p, __ATOMIC_RELAXED, __HIP_MEMORY_SCOPE_AGENT); }
__device__ __forceinline__ unsigned xb_add(unsigned* p, unsigned v) { return __hip_atomic_fetch_add(p, v, __ATOMIC_RELAXED, __HIP_MEMORY_SCOPE_AGENT); }
__device__ __forceinline__ unsigned xb_xcc_id() { return (unsigned)__builtin_amdgcn_s_getreg((3 << 11) | 20) & 0xFu; }
#define XB_SPIN(cond, bar) do { unsigned _sp = 0; while (cond) { __builtin_amdgcn_s_sleep(1); \
    if ((++_sp & 255u) == 0u) { if (xb_ld(&(bar)[XB_TMO])) break; if (_sp > XB_SPIN_CAP) { atomicAdd(&(bar)[XB_TMO], 1u); break; } } } } while (0)

struct XcdBarrier {
    unsigned* bar; unsigned x;
    volatile LAS unsigned* st;
};

__device__ __forceinline__ XcdBarrier xcd_barrier_post(unsigned* bar, volatile LAS unsigned* st) {
    XcdBarrier b; b.bar = bar; b.x = xb_xcc_id(); b.st = st;
    if (threadIdx.x == 0) (void)xb_add(&bar[XB_XCNT(b.x)], 1u);
    return b;
}
__device__ __forceinline__ void xcd_barrier_complete(unsigned* bar, unsigned x, unsigned& nloc, unsigned& nx) {
    const unsigned G = gridDim.x * gridDim.y * gridDim.z;
    unsigned sum, cnt, mine, sp = 0u;
    for (;;) {
        sum = 0u; cnt = 0u; mine = 0u;
#pragma unroll
        for (unsigned j = 0; j < 16; ++j) { const unsigned c = xb_ld(&bar[XB_XCNT(j)]); sum += c; cnt += (c > 0u) ? 1u : 0u; mine = (j == x) ? c : mine; }
        if (sum == G) break;
        __builtin_amdgcn_s_sleep(1);
        if ((++sp & 255u) == 0u) { if (xb_ld(&bar[XB_TMO])) break; if (sp > XB_SPIN_CAP) { atomicAdd(&bar[XB_TMO], 1u); break; } }
    }
    nloc = mine > 0u ? mine : 1u; nx = cnt > 0u ? cnt : 1u;
}

__device__ __forceinline__ void xcd_barrier(const XcdBarrier& b) {
    asm volatile("s_waitcnt vmcnt(0)" ::: "memory");
    __syncthreads();
    if (threadIdx.x == 0) {
        unsigned* bar = b.bar;
        __builtin_amdgcn_s_waitcnt(0);
        unsigned nloc = b.st[0], nx = b.st[1];
        if (nloc == 0u) { xcd_barrier_complete(bar, b.x, nloc, nx); b.st[0] = nloc; b.st[1] = nx; }
        const unsigned old = xb_add(&bar[XB_XSUB(b.x)], 1u);
        const unsigned gen = old / nloc;
        if (old + 1u == (gen + 1u) * nloc) {
            __builtin_amdgcn_fence(__ATOMIC_RELEASE, "agent");
            asm volatile("s_waitcnt vmcnt(0)" ::: "memory");
            const unsigned og = xb_add(&bar[XB_TOP], 1u);
            const unsigned tg = og / nx;
            if (og + 1u == (tg + 1u) * nx) xb_add(&bar[XB_TOPGEN], 1u);
            else XB_SPIN(xb_ld(&bar[XB_TOPGEN]) == tg, bar);
            __builtin_amdgcn_fence(__ATOMIC_ACQUIRE, "agent");
            xb_add(&bar[XB_XGEN(b.x)], 1u);
            asm volatile("s_waitcnt vmcnt(0)" ::: "memory");
        } else {
            XB_SPIN(xb_ld(&bar[XB_XGEN(b.x)]) == gen, bar);
            __builtin_amdgcn_fence(__ATOMIC_ACQUIRE, "agent");
            asm volatile("s_waitcnt vmcnt(0)" ::: "memory");
        }
    }
    __syncthreads();
}

struct Frame {
    LAS unsigned char* lds;
    volatile LAS unsigned* MISC;
    gu32* ctl;
    int wave;
    int vcu, G;
    const float *xp, *xs, *ck, *cv, *sconv, *norm_g, *w_in, *conv_w, *w_out, *final_g; float* out;
    bf16 *Win_t, *Wout_t, *H, *Qb, *Kb, *Vb, *Gs, *CU, *BG, *MIX;
};

__device__ __forceinline__ int fresh_lane() { int l; asm volatile("v_mbcnt_lo_u32_b32 %0, -1, 0\n\tv_mbcnt_hi_u32_b32 %0, -1, %0" : "=v"(l)); return l; }
__device__ __forceinline__ float wave_sum(float v) {
#pragma unroll
    for (int o = 1; o < 64; o <<= 1) v += __shfl_xor(v, o);
    return v;
}
__device__ __forceinline__ void p0_transpose_item(const float* W, int K, int N, bf16* WT, int k0, int n0, int drow0, LAS float* scr, int lane) {
#pragma unroll 8
    for (int i = 0; i < 32; ++i) { const int kk = 2 * i + (lane >> 5); scr[kk * 33 + (lane & 31)] = W[(size_t)(k0 + kk) * N + n0 + (lane & 31)]; }
    LDS_WAIT(); CFENCE();
    const int c = lane & 7;
#pragma unroll
    for (int j = 0; j < 4; ++j) { const int n = (lane >> 3) + 8 * j; const LAS float* s = scr + (8 * c) * 33 + n;
        v4u o; o.x = cvtpk(s[0 * 33], s[1 * 33]); o.y = cvtpk(s[2 * 33], s[3 * 33]); o.z = cvtpk(s[4 * 33], s[5 * 33]); o.w = cvtpk(s[6 * 33], s[7 * 33]);
        *(GAS v4u*)(WT + (size_t)(drow0 + n) * K + k0 + 8 * c) = o; }
    LDS_WAIT(); CFENCE();
}
__device__ __forceinline__ int win_dest_row(int n) {
    if (n < 4096) return n;
    const int s = (n - 4096) >> 10, ch = (n - 4096) & 1023, j = ch >> 7, cc = ch & 127;
    const int tile = (s == 1 || s == 2) ? 16 + j : 24 + j, half = (s == 2 || s == 3) ? 128 : 0;
    return tile * 256 + half + cc;
}
__device__ __forceinline__ void rms_row_to_bf16(const float* xrow, const float* g, bf16* orow, int lane) {
    const GAS f32x4* xr = (const GAS f32x4*)xrow + lane; const GAS f32x4* gr = (const GAS f32x4*)g + lane;
    f32x4 v[8]; float s = 0.f;
#pragma unroll
    for (int j = 0; j < 8; ++j) { v[j] = xr[64 * j]; s += (v[j].x * v[j].x + v[j].y * v[j].y) + (v[j].z * v[j].z + v[j].w * v[j].w); }
    const float r = 1.0f / sqrtf(wave_sum(s) * (1.f / DM) + EPS);
    GAS v2u* o8 = (GAS v2u*)orow + lane;
#pragma unroll
    for (int j = 0; j < 8; ++j) { const f32x4 gg = gr[64 * j]; v2u w; w.x = cvtpk((v[j].x * r) * gg.x, (v[j].y * r) * gg.y); w.y = cvtpk((v[j].z * r) * gg.z, (v[j].w * r) * gg.w); o8[64 * j] = w; }
}
__device__ __forceinline__ void p0_prologue(Frame& F) {
    LAS float* scr = (LAS float*)(F.lds + RING_OFF + F.wave * 16384);
    const int gw = F.vcu * NWAVES + F.wave, NGW = F.G * NWAVES, lane = fresh_lane();
    constexpr int I_IN = (DM / 64) * (DIN / 32), I_OUT = (DM / 64) * (DM / 32);
    for (int it = gw; it < I_IN + I_OUT; it += NGW) {
        if (it < I_IN) { const int kb = it / (DIN / 32), nb = it % (DIN / 32); p0_transpose_item(F.w_in, DM, DIN, F.Win_t, 64 * kb, 32 * nb, win_dest_row(32 * nb), scr, lane); }
        else { const int r = it - I_IN, kb = r / (DM / 32), nb = r % (DM / 32); p0_transpose_item(F.w_out, DM, DM, F.Wout_t, 64 * kb, 32 * nb, 32 * nb, scr, lane); }
    }
    for (int m = gw; m < MT; m += NGW) rms_row_to_bf16(m < MP ? F.xp + (size_t)m * DM : F.xs + (size_t)(m - MP) * DM, F.norm_g, F.H + (size_t)m * DM, lane);
}
__device__ __forceinline__ void p4_final_norm(Frame& F) {
    const int gw = F.vcu * NWAVES + F.wave, NGW = F.G * NWAVES, lane = fresh_lane();
    for (int m = gw; m < MT; m += NGW) {
        GAS f32x4* yr = (GAS f32x4*)(F.out + O_Y + (size_t)m * DM) + lane; const GAS f32x4* gr = (const GAS f32x4*)F.final_g + lane;
        f32x4 v[8]; float s = 0.f;
#pragma unroll
        for (int j = 0; j < 8; ++j) { v[j] = yr[64 * j]; s += (v[j].x * v[j].x + v[j].y * v[j].y) + (v[j].z * v[j].z + v[j].w * v[j].w); }
        const float r = 1.0f / sqrtf(wave_sum(s) * (1.f / DM) + EPS);
#pragma unroll
        for (int j = 0; j < 8; ++j) { const f32x4 gg = gr[64 * j]; f32x4 o; o.x = (v[j].x * r) * gg.x; o.y = (v[j].y * r) * gg.y; o.z = (v[j].z * r) * gg.z; o.w = (v[j].w * r) * gg.w; yr[64 * j] = o; }
    }
}
__device__ __forceinline__ void unpack8(const v4u w, float (&f)[8]) { f[0] = bflo(w.x); f[1] = bfhi(w.x); f[2] = bflo(w.y); f[3] = bfhi(w.y); f[4] = bflo(w.z); f[5] = bfhi(w.z); f[6] = bflo(w.w); f[7] = bfhi(w.w); }
__device__ __forceinline__ void p2_convmix(Frame& F) {
    const int gw = F.vcu * NWAVES + F.wave, NGW = F.G * NWAVES, lane = fresh_lane();
    for (int item = gw; item < MT * 2; item += NGW) {
        const int row = item >> 1, ch = (item & 1) * 512 + lane * 8;
        const bool samp = row >= MP; const int t = samp ? ((row - MP) & (DS - 1)) : (row & (SEQ - 1)); const int b = samp ? ((row - MP) >> 5) : (row >> 11);
        float c0[8], c1[8], c2[8], g[8];
        unpack8(*(const GAS v4u*)(F.CU + (size_t)row * DH + ch), c0);
        unpack8(*(const GAS v4u*)(F.BG + (size_t)row * DH + ch), g);
        if (t >= 1) unpack8(*(const GAS v4u*)(F.CU + (size_t)(row - 1) * DH + ch), c1);
        else if (samp) { const f32x4 a = *(const GAS f32x4*)(F.sconv + (size_t)(b * 2 + 1) * DH + ch), bq = *(const GAS f32x4*)(F.sconv + (size_t)(b * 2 + 1) * DH + ch + 4);
            c1[0] = a.x; c1[1] = a.y; c1[2] = a.z; c1[3] = a.w; c1[4] = bq.x; c1[5] = bq.y; c1[6] = bq.z; c1[7] = bq.w; }
        else {
#pragma unroll
            for (int i = 0; i < 8; ++i) c1[i] = 0.f; }
        if (t >= 2) unpack8(*(const GAS v4u*)(F.CU + (size_t)(row - 2) * DH + ch), c2);
        else if (samp) { const f32x4 a = *(const GAS f32x4*)(F.sconv + (size_t)(b * 2 + t) * DH + ch), bq = *(const GAS f32x4*)(F.sconv + (size_t)(b * 2 + t) * DH + ch + 4);
            c2[0] = a.x; c2[1] = a.y; c2[2] = a.z; c2[3] = a.w; c2[4] = bq.x; c2[5] = bq.y; c2[6] = bq.z; c2[7] = bq.w; }
        else {
#pragma unroll
            for (int i = 0; i < 8; ++i) c2[i] = 0.f; }
        float w0[8], w1[8], w2[8];
        { const GAS f32x4* p = (const GAS f32x4*)(F.conv_w + ch); const f32x4 a = p[0], bq = p[1]; w0[0] = a.x; w0[1] = a.y; w0[2] = a.z; w0[3] = a.w; w0[4] = bq.x; w0[5] = bq.y; w0[6] = bq.z; w0[7] = bq.w; }
        { const GAS f32x4* p = (const GAS f32x4*)(F.conv_w + DH + ch); const f32x4 a = p[0], bq = p[1]; w1[0] = a.x; w1[1] = a.y; w1[2] = a.z; w1[3] = a.w; w1[4] = bq.x; w1[5] = bq.y; w1[6] = bq.z; w1[7] = bq.w; }
        { const GAS f32x4* p = (const GAS f32x4*)(F.conv_w + 2 * DH + ch); const f32x4 a = p[0], bq = p[1]; w2[0] = a.x; w2[1] = a.y; w2[2] = a.z; w2[3] = a.w; w2[4] = bq.x; w2[5] = bq.y; w2[6] = bq.z; w2[7] = bq.w; }
        float o[8];
#pragma unroll
        for (int i = 0; i < 8; ++i) o[i] = g[i] * ((w0[i] * c2[i] + w1[i] * c1[i]) + w2[i] * c0[i]);
        v4u w; w.x = cvtpk(o[0], o[1]); w.y = cvtpk(o[2], o[3]); w.z = cvtpk(o[4], o[5]); w.w = cvtpk(o[6], o[7]);
        *(GAS v4u*)(F.MIX + (size_t)row * DM + DH + ch) = w;
    }
}

namespace sb {
constexpr float EXIT_THR = -160.0f;
constexpr int KST = 272, VST = 320;
constexpr int QIMG_OFF = 32 * VST;
constexpr int ATT_REGION = 19456;
static_assert(QIMG_OFF + 32 * KST <= ATT_REGION && 8 * ATT_REGION <= LDSCTL_OFF, "attention LDS map");
typedef __amdgpu_buffer_rsrc_t rsrc_t;
__device__ __forceinline__ rsrc_t mk_rsrc(const void* p, unsigned bytes) { return __builtin_amdgcn_make_buffer_rsrc((void*)p, (short)0, (int)bytes, 0x00020000); }
__device__ __forceinline__ int crow(int r, int hi) { return (r & 3) + 8 * (r >> 2) + 4 * hi; }
__device__ __forceinline__ s16x4 vtr(LAS const char* p) { typedef short v4i16_t __attribute__((ext_vector_type(4))); return __builtin_bit_cast(s16x4, __builtin_amdgcn_ds_read_tr16_b64_v4i16((LAS v4i16_t*)p)); }

__device__ __forceinline__ void ld_bf16(v4u (&R)[8], rsrc_t rs, int soff, int lane) {
    const int voff = ((lane >> 4) * DH + (lane & 15) * 8) * 2;
#pragma unroll
    for (int i = 0; i < 8; ++i) R[i] = __builtin_bit_cast(v4u, __builtin_amdgcn_raw_buffer_load_b128(rs, voff, soff + i * (4 * DH * 2), 0));
}
__device__ __forceinline__ void st_k_bf16(LAS char* img, const v4u (&R)[8], int lane) {
    LAS char* p = img + (lane >> 4) * KST + (lane & 15) * 16;
#pragma unroll
    for (int i = 0; i < 8; ++i) *(LAS v4u*)(p + i * 4 * KST) = R[i];
}
__device__ __forceinline__ void st_v_bf16(LAS char* img, const v4u (&R)[8], int lane) {
    LAS char* p = img + (lane >> 4) * VST + (lane & 15) * 16;
#pragma unroll
    for (int i = 0; i < 8; ++i) *(LAS v4u*)(p + i * 4 * VST) = R[i];
}
__device__ __forceinline__ void ld_f32(f32x4 (&R)[16], rsrc_t rs, int soff, int lane) {
    const int voff = ((lane >> 5) * DH + (lane & 31) * 4) * 4;
#pragma unroll
    for (int i = 0; i < 16; ++i) R[i] = __builtin_bit_cast(f32x4, __builtin_amdgcn_raw_buffer_load_b128(rs, voff, soff + i * (2 * DH * 4), 0));
}
__device__ __forceinline__ void st_k_f32(LAS char* img, const f32x4 (&R)[16], int lane) {
    LAS char* p = img + (lane >> 5) * KST + (lane & 31) * 8;
#pragma unroll
    for (int i = 0; i < 16; ++i) { v2u w; w.x = cvtpk(R[i].x, R[i].y); w.y = cvtpk(R[i].z, R[i].w); *(LAS v2u*)(p + i * 2 * KST) = w; }
}
__device__ __forceinline__ void st_v_f32(LAS char* img, const f32x4 (&R)[16], int lane) {
    LAS char* p = img + (lane >> 5) * VST + (lane & 31) * 8;
#pragma unroll
    for (int i = 0; i < 16; ++i) { v2u w; w.x = cvtpk(R[i].x, R[i].y); w.y = cvtpk(R[i].z, R[i].w); *(LAS v2u*)(p + i * 2 * VST) = w; }
}
template <bool MASK>
__device__ __forceinline__ void sb_weights(const f32x16& st, float& run, bf16x8& wf0, bf16x8& wf1, int r32, int hi) {
    float lb[16], ex[16], T[4];
#pragma unroll
    for (int i = 0; i < 16; ++i) { const float z = st[i]; const float e = __builtin_amdgcn_exp2f(-__builtin_fabsf(z)); const float lp = __builtin_amdgcn_logf(1.0f + e);
        float a = __builtin_fminf(z, 0.f) - lp, l1 = __builtin_fminf(-z, 0.f) - lp;
        if (MASK) { if (crow(i, hi) >= r32) { a = -INFINITY; l1 = 0.f; } }
        lb[i] = a; ex[i] = l1; }
#pragma unroll
    for (int g = 0; g < 4; ++g) { const float l0 = ex[4 * g], l1 = ex[4 * g + 1], l2 = ex[4 * g + 2], l3 = ex[4 * g + 3];
        ex[4 * g + 3] = 0.f; ex[4 * g + 2] = l3; ex[4 * g + 1] = l3 + l2; ex[4 * g] = (l3 + l2) + l1; T[g] = ((l3 + l2) + l1) + l0; }
    float P[4], U[4];
#pragma unroll
    for (int g = 0; g < 4; ++g) { P[g] = __shfl_xor(T[g], 32); U[g] = T[g] + P[g]; }
    const float A2 = U[3], A1 = U[3] + U[2], A0 = A1 + U[1], tot = A0 + U[0];
    float off[4]; off[3] = run; off[2] = run + A2; off[1] = run + A1; off[0] = run + A0;
    if (hi == 0) {
#pragma unroll
        for (int g = 0; g < 4; ++g) off[g] += P[g]; }
    float w[16];
#pragma unroll
    for (int i = 0; i < 16; ++i) w[i] = __builtin_amdgcn_exp2f(lb[i] + (off[i >> 2] + ex[i]));
    run += tot;
    v4u a, b; a.x = cvtpk(w[0], w[1]); a.y = cvtpk(w[2], w[3]); a.z = cvtpk(w[4], w[5]); a.w = cvtpk(w[6], w[7]);
    b.x = cvtpk(w[8], w[9]); b.y = cvtpk(w[10], w[11]); b.z = cvtpk(w[12], w[13]); b.w = cvtpk(w[14], w[15]);
    wf0 = __builtin_bit_cast(bf16x8, a); wf1 = __builtin_bit_cast(bf16x8, b);
}
template <bool MASK>
__device__ __forceinline__ void s_part(LAS const char* img, LAS const char* Qimg, float& run, bf16x8& wf0, bf16x8& wf1, int r32, int hi) {
    f32x16 st;
#pragma unroll
    for (int i = 0; i < 16; ++i) st[i] = 0.f;
    const int fo = r32 * KST + hi * 16;
#pragma unroll
    for (int s = 0; s < 8; ++s) { const bf16x8 kf = *(LAS const bf16x8*)(img + fo + 32 * s), qf = *(LAS const bf16x8*)(Qimg + fo + 32 * s); st = __builtin_amdgcn_mfma_f32_32x32x16_bf16(kf, qf, st, 0, 0, 0); }
    sb_weights<MASK>(st, run, wf0, wf1, r32, hi);
}
__device__ __forceinline__ void pv_part(LAS const char* img, f32x16 (&o)[4], const bf16x8 wf0, const bf16x8 wf1, int lane) {
    const int i = lane & 15, q4 = i >> 2, p = i & 3, hi = lane >> 5;
    LAS const char* vb = img + (4 * hi + q4) * VST + 32 * ((lane >> 4) & 1) + 8 * p;
#pragma unroll
    for (int dblk = 0; dblk < 4; ++dblk)
#pragma unroll
        for (int s = 0; s < 2; ++s) {
            const s16x4 lo = vtr(vb + 16 * s * VST + 64 * dblk), hh = vtr(vb + (16 * s + 8) * VST + 64 * dblk);
            const bf16x8 vf = (bf16x8){lo[0], lo[1], lo[2], lo[3], hh[0], hh[1], hh[2], hh[3]};
            o[dblk] = __builtin_amdgcn_mfma_f32_32x32x16_bf16(vf, s ? wf1 : wf0, o[dblk], 0, 0, 0); }
}
template <bool MASK>
__device__ __forceinline__ void tile_bf16(v4u (&R)[8], rsrc_t rk, rsrc_t rv, int vo, int kno, f32x16 (&o)[4], float& run, LAS char* img, LAS char* Qimg, int lane) {
    st_k_bf16(img, R, lane);
    ld_bf16(R, rv, vo, lane);
    CFENCE();
    bf16x8 wf0, wf1;
    s_part<MASK>(img, Qimg, run, wf0, wf1, lane & 31, lane >> 5);
    CFENCE();
    st_v_bf16(img, R, lane);
    ld_bf16(R, rk, kno, lane);
    CFENCE();
    pv_part(img, o, wf0, wf1, lane);
    CFENCE();
}
template <bool EARLY>
__device__ __forceinline__ void range_bf16(rsrc_t rk, rsrc_t rv, int off0, int tau_hi, int tau_lo, bool first_masked, f32x16 (&o)[4], float& run, LAS char* img, LAS char* Qimg, int lane) {
    if (tau_hi < tau_lo) return;
    constexpr int TB = 32 * DH * 2;
    v4u R[8];
    ld_bf16(R, rk, off0 + tau_hi * TB, lane);
    int tau = tau_hi;
    if (first_masked) { tile_bf16<true>(R, rk, rv, off0 + tau * TB, off0 + (tau > tau_lo ? tau - 1 : tau) * TB, o, run, img, Qimg, lane); --tau; }
    for (; tau >= tau_lo; --tau) {
        tile_bf16<false>(R, rk, rv, off0 + tau * TB, off0 + (tau > tau_lo ? tau - 1 : tau) * TB, o, run, img, Qimg, lane);
        if (EARLY) { if (__all(run < EXIT_THR)) break; }
    }
}
__device__ __forceinline__ void tile_f32(f32x4 (&R)[16], rsrc_t rk, rsrc_t rv, int vo, int kno, f32x16 (&o)[4], float& run, LAS char* img, LAS char* Qimg, int lane) {
    st_k_f32(img, R, lane);
    ld_f32(R, rv, vo, lane);
    CFENCE();
    bf16x8 wf0, wf1;
    s_part<false>(img, Qimg, run, wf0, wf1, lane & 31, lane >> 5);
    CFENCE();
    st_v_f32(img, R, lane);
    ld_f32(R, rk, kno, lane);
    CFENCE();
    pv_part(img, o, wf0, wf1, lane);
    CFENCE();
}
template <bool EARLY>
__device__ __forceinline__ void range_f32(rsrc_t rk, rsrc_t rv, int off0, int tau_hi, int tau_lo, f32x16 (&o)[4], float& run, LAS char* img, LAS char* Qimg, int lane) {
    if (tau_hi < tau_lo) return;
    constexpr int TB = 32 * DH * 4;
    f32x4 R[16];
    ld_f32(R, rk, off0 + tau_hi * TB, lane);
    for (int tau = tau_hi; tau >= tau_lo; --tau) {
        tile_f32(R, rk, rv, off0 + tau * TB, off0 + (tau > tau_lo ? tau - 1 : tau) * TB, o, run, img, Qimg, lane);
        if (EARLY) { if (__all(run < EXIT_THR)) break; }
    }
}
__device__ __forceinline__ void load_q(LAS char* Qimg, rsrc_t rq, int soff  , int lane) {
    v4u R[8]; ld_bf16(R, rq, soff, lane); st_k_bf16(Qimg, R, lane); CFENCE();
}
__device__ __forceinline__ void zero_o(f32x16 (&o)[4]) {
#pragma unroll
    for (int d = 0; d < 4; ++d)
#pragma unroll
        for (int i = 0; i < 16; ++i) o[d][i] = 0.f;
}
__device__ __forceinline__ void epi_store(const f32x16 (&o)[4], const bf16* Gs_row, bf16* MIX_row, int hi) {
#pragma unroll
    for (int dblk = 0; dblk < 4; ++dblk)
#pragma unroll
        for (int g = 0; g < 4; ++g) { const int d0 = 32 * dblk + 8 * g + 4 * hi; const v2u gg = *(const GAS v2u*)(Gs_row + d0);
            v2u w; w.x = cvtpk(o[dblk][4 * g] * bflo(gg.x), o[dblk][4 * g + 1] * bfhi(gg.x)); w.y = cvtpk(o[dblk][4 * g + 2] * bflo(gg.y), o[dblk][4 * g + 3] * bfhi(gg.y));
            *(GAS v2u*)(MIX_row + d0) = w; }
}
struct Ctx { const bf16 *Qb, *Kb, *Vb, *Gs; bf16* MIX; const float *ck, *cv; };

__device__ __forceinline__ void ldq(v4u (&S)[2], rsrc_t rs, int soff, int wq, int lane) {
    const int voff = ((8 * wq + (lane >> 4)) * DH + (lane & 15) * 8) * 2;
    S[0] = __builtin_bit_cast(v4u, __builtin_amdgcn_raw_buffer_load_b128(rs, voff, soff, 0));
    S[1] = __builtin_bit_cast(v4u, __builtin_amdgcn_raw_buffer_load_b128(rs, voff, soff + 4 * DH * 2, 0));
}
__device__ __forceinline__ void stq(LAS char* img, int pitch, const v4u (&S)[2], int wq, int lane) {
    LAS char* p = img + (8 * wq + (lane >> 4)) * pitch + (lane & 15) * 16;
    *(LAS v4u*)p = S[0]; *(LAS v4u*)(p + 4 * pitch) = S[1];
}
template <bool MASK>
__device__ __forceinline__ void s_part_q(LAS const char* img, const bf16x8 (&qf)[8], float& run, bf16x8& wf0, bf16x8& wf1, int r32, int hi) {
    f32x16 st;
#pragma unroll
    for (int i = 0; i < 16; ++i) st[i] = 0.f;
    const int fo = r32 * KST + hi * 16;
#pragma unroll
    for (int s = 0; s < 8; ++s) { const bf16x8 kf = *(LAS const bf16x8*)(img + fo + 32 * s); st = __builtin_amdgcn_mfma_f32_32x32x16_bf16(kf, qf[s], st, 0, 0, 0); }
    sb_weights<MASK>(st, run, wf0, wf1, r32, hi);
}
__device__ __forceinline__ void load_qf(bf16x8 (&qf)[8], const bf16* Qrow, int hi) {
#pragma unroll
    for (int s = 0; s < 8; ++s) qf[s] = *(const GAS bf16x8*)(Qrow + 16 * s + 8 * hi);
}
constexpr int PG_BYTES = 2 * 32 * KST + 2 * 32 * VST;
static_assert(2 * PG_BYTES <= LDSCTL_OFF && 4 * 16384 <= 2 * PG_BYTES, "prompt LDS map");

template <bool EARLY>
__device__ __forceinline__ void prompt_unit(LAS unsigned char* lds, const Ctx& C, rsrc_t rK, rsrc_t rV, int unit, int wave, int lane) {
    const int r32 = lane & 31, hi = lane >> 5, grp = wave >> 2, wq = wave & 3;
    const int bh = unit >> 3, b = bh >> 3, h = bh & 7, j = unit & 7, B = 15 - j, nA = 4 * j + 4;
    const int s0 = (b * SEQ * DH + h * HD) * 2; constexpr int TB = 32 * DH * 2;
    LAS char* gb = (LAS char*)lds + grp * PG_BYTES;
    LAS float* xch = (LAS float*)((LAS char*)lds + XCH_OFF);
#define KT_OF(n) (grp ? (4 * B + 3 - (n)) : ((n) < nA ? (nA - 1 - (n)) : (29 - 4 * j - ((n) - nA))))
#define KBUF(i) (gb + (i) * (32 * KST))
#define VBUF(i) (gb + 2 * 32 * KST + (i) * (32 * VST))
    int X = grp ? B : j, qt = 4 * X + wq;
    bf16x8 qf[8]; load_qf(qf, C.Qb + ((size_t)b * SEQ + 32 * qt + r32) * DH + h * HD, hi);
    f32x16 o[4]; zero_o(o); float run = 0.f;
    v4u SK[2], SV[2];
    { const int kt0 = KT_OF(0); ldq(SK, rK, s0 + kt0 * TB, wq, lane); ldq(SV, rV, s0 + kt0 * TB, wq, lane); }
    stq(KBUF(0), KST, SK, wq, lane); stq(VBUF(0), VST, SV, wq, lane);
    { const int kt1 = KT_OF(1); ldq(SK, rK, s0 + kt1 * TB, wq, lane); ldq(SV, rV, s0 + kt1 * TB, wq, lane); }
    __syncthreads();
    for (int n = 0; n < 34; ++n) {
        if (n + 1 < 34) { stq(KBUF((n + 1) & 1), KST, SK, wq, lane); stq(VBUF((n + 1) & 1), VST, SV, wq, lane); }
        if (n + 2 < 34) { const int kt2 = KT_OF(n + 2); ldq(SK, rK, s0 + kt2 * TB, wq, lane); ldq(SV, rV, s0 + kt2 * TB, wq, lane); }
        if (grp == 0 && n == nA) {
            const size_t qrow = (size_t)b * SEQ + 32 * qt + r32;
            epi_store(o, C.Gs + qrow * DH + h * HD, C.MIX + qrow * DM + h * HD, hi);
            X = B; qt = 4 * X + wq; load_qf(qf, C.Qb + ((size_t)b * SEQ + 32 * qt + r32) * DH + h * HD, hi); zero_o(o); run = 0.f;
        }
        const int kt = KT_OF(n);
        bool live = kt <= qt;
        if (EARLY) { if (__all(run < EXIT_THR)) live = false; }
        if (live) {
            bf16x8 wf0, wf1;
            if (kt == qt) s_part_q<true>(KBUF(n & 1), qf, run, wf0, wf1, r32, hi); else s_part_q<false>(KBUF(n & 1), qf, run, wf0, wf1, r32, hi);
            pv_part(VBUF(n & 1), o, wf0, wf1, lane);
        }
        __syncthreads();
    }
    if (grp == 1 && hi == 0) xch[wq * 32 + r32] = run;
    __syncthreads();
    LAS float* rg = (LAS float*)((LAS char*)lds + wq * 16384);
    if (grp == 0) {
        const float f = __builtin_amdgcn_exp2f(xch[wq * 32 + r32]);
#pragma unroll
        for (int d = 0; d < 4; ++d)
#pragma unroll
            for (int k = 0; k < 16; ++k) rg[(d * 16 + k) * 64 + lane] = o[d][k] * f;
    }
    __syncthreads();
    if (grp == 1) {
#pragma unroll
        for (int d = 0; d < 4; ++d)
#pragma unroll
            for (int k = 0; k < 16; ++k) o[d][k] += rg[(d * 16 + k) * 64 + lane];
        const size_t qrow = (size_t)b * SEQ + 32 * qt + r32;
        epi_store(o, C.Gs + qrow * DH + h * HD, C.MIX + qrow * DM + h * HD, hi);
    }
    __syncthreads();
#undef KT_OF
#undef KBUF
#undef VBUF
}
template <bool EARLY>
__device__ __forceinline__ void sample_unit(LAS unsigned char* lds, const Ctx& C, rsrc_t rQ, rsrc_t rK, rsrc_t rV, rsrc_t rCK, rsrc_t rCV, int unit, int wave, int lane) {
    LAS char* region = (LAS char*)lds + wave * ATT_REGION; LAS char* img = region; LAS char* Qimg = region + QIMG_OFF;
    LAS float* xch = (LAS float*)((LAS char*)lds + XCH_OFF);
    const int r32 = lane & 31, hi = lane >> 5;
    const int b = unit >> 3, h = unit & 7; const size_t qrow = (size_t)MP + 32 * b + r32;
    const int new0 = ((MP + 32 * b) * DH + h * HD) * 2;
    const int c0 = (b * PAST * DH + h * HD) * 4;
    load_q(Qimg, rQ, new0, lane);
    f32x16 o[4]; zero_o(o); float run = 0.f;
    if (wave == 7) {
        range_bf16<false>(rK, rV, new0, 0, 0, true, o, run, img, Qimg, lane);
        range_f32<EARLY>(rCK, rCV, c0, 31, 28, o, run, img, Qimg, lane);
    } else range_f32<EARLY>(rCK, rCV, c0, 4 * wave + 3, 4 * wave, o, run, img, Qimg, lane);
    if (hi == 0) xch[wave * 32 + r32] = run;
    __syncthreads();
    float fs = 0.f;
    for (int w2 = wave + 1; w2 < 8; ++w2) fs += xch[w2 * 32 + r32];
    const float f = __builtin_amdgcn_exp2f(fs);
    LAS float* rg = (LAS float*)region;
#pragma unroll
    for (int d = 0; d < 4; ++d)
#pragma unroll
        for (int i = 0; i < 16; ++i) rg[(d * 16 + i) * 64 + lane] = o[d][i] * f;
    __syncthreads();
    float res[8];
#pragma unroll
    for (int jx = 0; jx < 8; ++jx) { float s = 0.f;
#pragma unroll
        for (int w2 = 0; w2 < 8; ++w2) s += ((LAS const float*)((LAS const char*)lds + w2 * ATT_REGION))[(8 * wave + jx) * 64 + lane];
        res[jx] = s; }
    const bf16* Gs_row = C.Gs + qrow * DH + h * HD; bf16* MIX_row = C.MIX + qrow * DM + h * HD;
#pragma unroll
    for (int jj = 0; jj < 2; ++jj) { const int d0 = 32 * (wave >> 1) + 8 * (2 * (wave & 1) + jj) + 4 * hi; const v2u gg = *(const GAS v2u*)(Gs_row + d0);
        v2u w; w.x = cvtpk(res[4 * jj] * bflo(gg.x), res[4 * jj + 1] * bfhi(gg.x)); w.y = cvtpk(res[4 * jj + 2] * bflo(gg.y), res[4 * jj + 3] * bfhi(gg.y));
        *(GAS v2u*)(MIX_row + d0) = w; }
    __syncthreads();
}
template <bool EARLY>
__device__ __forceinline__ void attn_phase(LAS unsigned char* lds, const Ctx& C, int vcu, int parts  , int wave, int lane) {
    const rsrc_t rQ = mk_rsrc(C.Qb, (unsigned)MT * DH * 2), rK = mk_rsrc(C.Kb, (unsigned)MT * DH * 2), rV = mk_rsrc(C.Vb, (unsigned)MT * DH * 2);
    const rsrc_t rCK = mk_rsrc(C.ck, (unsigned)DB * PAST * DH * 4), rCV = mk_rsrc(C.cv, (unsigned)DB * PAST * DH * 4);
    const int unit = vcu;
    if (unit < 256)
        for (int part = 0; part < 2; ++part) {
            if ((part ^ unit) & 1) { if (parts & 2) prompt_unit<EARLY>(lds, C, rK, rV, unit, wave, lane); }
            else { if (parts & 1) sample_unit<EARLY>(lds, C, rQ, rK, rV, rCK, rCV, unit, wave, lane); }
        }
}
}

struct Args { const float* in[10]; float* out; unsigned char* ws; int ph_mask; int pad; };
#ifndef SB_EARLY
#define SB_EARLY false
#endif
__global__ void __launch_bounds__(NWAVES * 64, 2) mk_fwd(Args args) {
    extern __shared__ __attribute__((aligned(16))) unsigned char lds[];
    Frame F;
    F.lds = (LAS unsigned char*)lds;
    F.MISC = (volatile LAS unsigned*)(F.lds + MISC_OFF);
    F.wave = __builtin_amdgcn_readfirstlane(threadIdx.x >> 6);
    F.G = gridDim.x; { const int bx = blockIdx.x; F.vcu = (F.G % 8 == 0) ? (bx % 8) * (F.G / 8) + bx / 8 : bx; }
    unsigned char* ws = args.ws;
    F.ctl = (gu32*)(ws + WS_CTL);
    F.xp = args.in[0]; F.xs = args.in[1]; F.ck = args.in[2]; F.cv = args.in[3]; F.sconv = args.in[4]; F.norm_g = args.in[5]; F.w_in = args.in[6]; F.conv_w = args.in[7]; F.w_out = args.in[8]; F.final_g = args.in[9];
    F.out = args.out;
    F.Win_t = (bf16*)(ws + WS_WIN); F.Wout_t = (bf16*)(ws + WS_WOUT); F.H = (bf16*)(ws + WS_H); F.Qb = (bf16*)(ws + WS_Q); F.Kb = (bf16*)(ws + WS_K); F.Vb = (bf16*)(ws + WS_V);
    F.Gs = (bf16*)(ws + WS_GS); F.CU = (bf16*)(ws + WS_CU); F.BG = (bf16*)(ws + WS_BG); F.MIX = (bf16*)(ws + WS_MIX);
    for (int u = threadIdx.x; u < (LDS_BYTES - LDSCTL_OFF) / 4; u += NWAVES * 64) ((LAS unsigned*)(F.lds + LDSCTL_OFF))[u] = 0u;
    __syncthreads();
    const int pm = args.ph_mask;
    const bool multi = (pm & (pm - 1)) != 0 && pm != 12;
    XcdBarrier bar; bar.bar = (unsigned*)(F.ctl + 4096); bar.x = 0; bar.st = nullptr;
    if (multi) bar = xcd_barrier_post((unsigned*)(F.ctl + 4096), F.MISC + 8);
#define SEAM(rest) do { if (multi && (pm & (rest))) xcd_barrier(bar); } while (0)

    if (pm & 1) { p0_prologue(F); SEAM(62); }
    if (pm & 2) {
        pg8::Gemm g{F.H, F.Win_t, MT, DIN, DM}; pg8::StaticOrder S; S.init(MT, DIN, F.G, (int)blockIdx.x);
        pg8::Epi1 E{F.Qb, F.Kb, F.Vb, F.Gs, F.CU, F.BG, F.out};
        pg8::gemm_phase<pg8::Epi1, pg8::StaticOrder, true, true>(F.lds + RING_OFF, g, S, E);
        SEAM(60);
    }
    if (pm & (4 | 64 | 128)) { const sb::Ctx C{F.Qb, F.Kb, F.Vb, F.Gs, F.MIX, F.ck, F.cv}; sb::attn_phase<SB_EARLY>(F.lds, C, F.vcu, (pm & 4) ? 3 : ((pm >> 6) & 3), F.wave, fresh_lane()); }
    if (pm & 8) { p2_convmix(F); }
    if (pm & 12) { SEAM(48); }
    if (pm & 16) {
        pg8::Gemm g{F.MIX, F.Wout_t, MT, DM, DM}; pg8::StaticOrder S; S.init(MT, DM, F.G, (int)blockIdx.x);
        pg8::Epi2 E{F.xp, F.xs, F.out + O_Y};
        pg8::gemm_phase<pg8::Epi2, pg8::StaticOrder, true, true>(F.lds + RING_OFF, g, S, E);
        SEAM(32);
    }
    if (pm & 32) { p4_final_norm(F); }
#undef SEAM
}

#ifndef NAIVE_P1
#define NAIVE_P1 0
#endif
#ifndef NAIVE_P2
#define NAIVE_P2 0
#endif
#ifndef NAIVE_P3
#define NAIVE_P3 0
#endif
#ifndef ONE_LAUNCH
#define ONE_LAUNCH 1
#endif
#if NAIVE_P1 || NAIVE_P3
__global__ void __launch_bounds__(256) gemm_naive(const bf16* A, const bf16* Bt, float* C, int M, int N, int K) {
    __shared__ float As[32][65], Bs[32][65];
    const int t = threadIdx.x, tx = t & 15, ty = t >> 4, m0 = blockIdx.y * 64, n0 = blockIdx.x * 64;
    float acc[4][4];
#pragma unroll
    for (int i = 0; i < 4; ++i)
#pragma unroll
        for (int j = 0; j < 4; ++j) acc[i][j] = 0.f;
    for (int k0 = 0; k0 < K; k0 += 32) {
        { const v4u a = *(const v4u*)(A + (size_t)(m0 + (t >> 2)) * K + k0 + (t & 3) * 8); float f[8]; unpack8(a, f);
#pragma unroll
          for (int j = 0; j < 8; ++j) As[(t & 3) * 8 + j][t >> 2] = f[j]; }
        { const v4u a = *(const v4u*)(Bt + (size_t)(n0 + (t >> 2)) * K + k0 + (t & 3) * 8); float f[8]; unpack8(a, f);
#pragma unroll
          for (int j = 0; j < 8; ++j) Bs[(t & 3) * 8 + j][t >> 2] = f[j]; }
        __syncthreads();
#pragma unroll 8
        for (int kk = 0; kk < 32; ++kk) { float a[4], b[4];
#pragma unroll
            for (int i = 0; i < 4; ++i) { a[i] = As[kk][ty * 4 + i]; b[i] = Bs[kk][tx * 4 + i]; }
#pragma unroll
            for (int i = 0; i < 4; ++i)
#pragma unroll
                for (int j = 0; j < 4; ++j) acc[i][j] += a[i] * b[j]; }
        __syncthreads();
    }
#pragma unroll
    for (int i = 0; i < 4; ++i)
#pragma unroll
        for (int j = 0; j < 4; ++j) C[(size_t)(m0 + ty * 4 + i) * N + n0 + tx * 4 + j] = acc[i][j];
}
#endif
#if NAIVE_P1
__device__ __forceinline__ unsigned short f2bf1(float f) { return (unsigned short)(cvtpk(f, 0.f) & 0xffffu); }
__global__ void __launch_bounds__(256) epi1_naive(const float* C, bf16* Qb, bf16* Kb, bf16* Vb, bf16* Gs, bf16* CU, bf16* BG, float* out) {
    const size_t gid = (size_t)blockIdx.x * 256 + threadIdx.x; if (gid >= (size_t)MT * 32 * 128) return;
    const int cc = (int)(gid & 127), pn = (int)((gid >> 7) & 31), row = (int)(gid >> 12);
    const float v0 = C[(size_t)row * DIN + 256 * pn + cc], v1 = C[(size_t)row * DIN + 256 * pn + 128 + cc];
    if (pn < 16) {
        const int typ = pn >> 2;
        for (int k = 0; k < 2; ++k) { const int col = (pn & 3) * 256 + cc + 128 * k; float v = k ? v1 : v0;
            if (typ == 0) Qb[(size_t)row * DH + col] = f2bf1(v * C2);
            else if (typ == 3) Gs[(size_t)row * DH + col] = f2bf1(v / (1.f + expf(-v)));
            else { (typ == 1 ? Kb : Vb)[(size_t)row * DH + col] = f2bf1(v);
                   out[(row < MP ? (typ == 1 ? O_KP : O_VP) + (size_t)row * DH : (typ == 1 ? O_KS : O_VS) + (size_t)(row - MP) * DH) + col] = v; } }
    } else if (pn < 24) {
        const int ch = (pn - 16) * 128 + cc; const float cu = v0 * v1; CU[(size_t)row * DH + ch] = f2bf1(cu);
        if (row < MP) { const int t = row & (SEQ - 1); if (t >= SEQ - 2) out[O_CP + (size_t)((row >> 11) * 2 + (t - (SEQ - 2))) * DH + ch] = cu; }
        else { const int r2 = row - MP, t = r2 & (DS - 1); if (t >= DS - 2) out[O_CS + (size_t)((r2 >> 5) * 2 + (t - (DS - 2))) * DH + ch] = cu; }
    } else { const int ch = (pn - 24) * 128 + cc; BG[(size_t)row * DH + ch] = f2bf1(v0 * (v1 / (1.f + expf(-v1)))); }
}
#endif
#if NAIVE_P3
__global__ void __launch_bounds__(256) epi2_naive(const float* C, const float* xp, const float* xs, float* y) {
    const size_t gid = (size_t)blockIdx.x * 256 + threadIdx.x; if (gid >= (size_t)MT * DM) return;
    const size_t row = gid / DM, col = gid % DM; const float x = row < MP ? xp[row * DM + col] : xs[(row - MP) * DM + col];
    y[gid] = x + C[gid];
}
#endif
#if NAIVE_P2
__global__ void __launch_bounds__(256) attn_naive(const bf16* Qb, const bf16* Kb, const bf16* Vb, const bf16* Gs, const float* ck, const float* cv, bf16* MIX) {
    const int gw = blockIdx.x * 4 + (threadIdx.x >> 6), lane = threadIdx.x & 63; if (gw >= MT * NH) return;
    const int row = gw >> 3, h = gw & 7, d = 2 * lane;
    const float q0 = bf2f(Qb[(size_t)row * DH + h * HD + d]), q1 = bf2f(Qb[(size_t)row * DH + h * HD + d + 1]);
    float run = 0.f, o0 = 0.f, o1 = 0.f;
    int nnew, krow0, ncache = 0, b;
    if (row < MP) { b = row >> 11; nnew = row & (SEQ - 1); krow0 = b * SEQ; } else { const int r2 = row - MP; b = r2 >> 5; nnew = r2 & (DS - 1); krow0 = MP + b * DS; ncache = PAST; }
    for (int j = nnew - 1; j >= 0; --j) {
        const size_t kr = (size_t)(krow0 + j) * DH + h * HD + d;
        float p = q0 * bf2f(Kb[kr]) + q1 * bf2f(Kb[kr + 1]);
#pragma unroll
        for (int s = 1; s < 64; s <<= 1) p += __shfl_xor(p, s);
        const float z = p, e = exp2f(-fabsf(z)), lp = log2f(1.f + e), lb = fminf(z, 0.f) - lp, l1 = fminf(-z, 0.f) - lp, w = exp2f(lb + run);
        o0 += w * bf2f(Vb[kr]); o1 += w * bf2f(Vb[kr + 1]); run += l1;
    }
    for (int j = ncache - 1; j >= 0; --j) {
        const size_t kr = ((size_t)b * PAST + j) * DH + h * HD + d;
        float p = q0 * ck[kr] + q1 * ck[kr + 1];
#pragma unroll
        for (int s = 1; s < 64; s <<= 1) p += __shfl_xor(p, s);
        const float z = p, e = exp2f(-fabsf(z)), lp = log2f(1.f + e), lb = fminf(z, 0.f) - lp, l1 = fminf(-z, 0.f) - lp, w = exp2f(lb + run);
        o0 += w * cv[kr]; o1 += w * cv[kr + 1]; run += l1;
    }
    const size_t gi = (size_t)row * DH + h * HD + d;
    const unsigned w = cvtpk(o0 * bf2f(Gs[gi]), o1 * bf2f(Gs[gi + 1]));
    *(unsigned*)(MIX + (size_t)row * DM + h * HD + d) = w;
}
#endif

extern "C" void kernel_launch(void* const* d_in, const int* in_sizes, int n_in, void* d_out, int out_size, void* d_ws, size_t ws_size, hipStream_t stream) {
    static int grid = 0;
    if (grid == 0) {
        if (n_in != 10 || (size_t)out_size != O_END || ws_size < 512 * MiB) { fprintf(stderr, "kernel_launch: unexpected sizes: n_in %d out %d ws %zu; nothing launched\n", n_in, out_size, ws_size); grid = -1; return; }
        int dev = 0, cus = 0, per_cu = 0;
        if (hipGetDevice(&dev) != hipSuccess || hipDeviceGetAttribute(&cus, hipDeviceAttributeMultiprocessorCount, dev) != hipSuccess) { grid = -1; return; }
        if (hipFuncSetAttribute((const void*)mk_fwd, hipFuncAttributeMaxDynamicSharedMemorySize, LDS_BYTES) != hipSuccess) { fprintf(stderr, "kernel_launch: hipFuncSetAttribute failed\n"); grid = -1; return; }
        if (hipOccupancyMaxActiveBlocksPerMultiprocessor(&per_cu, (const void*)mk_fwd, NWAVES * 64, LDS_BYTES) != hipSuccess || per_cu < 1) { fprintf(stderr, "kernel_launch: occupancy query says %d blocks per CU\n", per_cu); grid = -1; (void)hipGetLastError(); return; }
        if (cus != 256) { fprintf(stderr, "kernel_launch: built for a 256-CU device (one attention unit pair per workgroup), found %d CUs; nothing launched\n", cus); grid = -1; return; }
        grid = cus;
    }
    if (grid < 0) return;
    (void)hipMemsetAsync((char*)d_ws + WS_CTL, 0, CTL_ZERO_BYTES, stream);
    Args a{};
    for (int i = 0; i < 10; ++i) a.in[i] = (const float*)d_in[i];
    a.out = (float*)d_out; a.ws = (unsigned char*)d_ws;
    unsigned char* ws = (unsigned char*)d_ws;
#if ONE_LAUNCH
    a.ph_mask = 63;
    void* kargs[] = {&a};
    hipError_t e = hipLaunchCooperativeKernel((const void*)mk_fwd, dim3(grid), dim3(NWAVES * 64), kargs, LDS_BYTES, stream);
    if (e != hipSuccess) fprintf(stderr, "kernel_launch: cooperative launch failed: %s (grid %d)\n", hipGetErrorString(e), grid);
#else
#ifndef PROBE_DUP
#define PROBE_DUP 0
#endif
#define LAUNCH_PH(mask) do { a.ph_mask = (mask); for (int rep_ = 0; rep_ < ((PROBE_DUP & (mask)) == (mask) ? 2 : 1); ++rep_) hipLaunchKernelGGL(mk_fwd, dim3(grid), dim3(NWAVES * 64), LDS_BYTES, stream, a); } while (0)
    LAUNCH_PH(1);
#if NAIVE_P1
    gemm_naive<<<dim3(DIN / 64, MT / 64), 256, 0, stream>>>((const bf16*)(ws + WS_H), (const bf16*)(ws + WS_WIN), (float*)(ws + WS_TMP), MT, DIN, DM);
    epi1_naive<<<(unsigned)(((size_t)MT * 32 * 128 + 255) / 256), 256, 0, stream>>>((const float*)(ws + WS_TMP), (bf16*)(ws + WS_Q), (bf16*)(ws + WS_K), (bf16*)(ws + WS_V), (bf16*)(ws + WS_GS), (bf16*)(ws + WS_CU), (bf16*)(ws + WS_BG), (float*)d_out);
#else
    LAUNCH_PH(2);
#endif
#if NAIVE_P2
    attn_naive<<<MT * NH / 4, 256, 0, stream>>>((const bf16*)(ws + WS_Q), (const bf16*)(ws + WS_K), (const bf16*)(ws + WS_V), (const bf16*)(ws + WS_GS), (const float*)d_in[2], (const float*)d_in[3], (bf16*)(ws + WS_MIX));
    LAUNCH_PH(8);
#else
#if defined(PROBE_SPLIT_ATTN)
    LAUNCH_PH(64); LAUNCH_PH(128); LAUNCH_PH(8);
#else
    LAUNCH_PH(4); LAUNCH_PH(8);
#endif
#endif
#if NAIVE_P3
    gemm_naive<<<dim3(DM / 64, MT / 64), 256, 0, stream>>>((const bf16*)(ws + WS_MIX), (const bf16*)(ws + WS_WOUT), (float*)(ws + WS_TMP), MT, DM, DM);
    epi2_naive<<<(unsigned)(((size_t)MT * DM + 255) / 256), 256, 0, stream>>>((const float*)(ws + WS_TMP), (const float*)d_in[0], (const float*)d_in[1], (float*)d_out + O_Y);
#else
    LAUNCH_PH(16);
#endif
    LAUNCH_PH(32);
#endif
    (void)ws;
}
```

```cpp
#include <hip/hip_runtime.h>
#include <cstdio>
#include <cstdint>

constexpr int DM = 2048;
constexpr int NB = 4, SEQ = 2048;
constexpr int DB = 32, DS = 32, PAST = 1024;
constexpr int MP = NB * SEQ;
constexpr int MS = DB * DS;
constexpr int MT = MP + MS;
constexpr int DIN = 8192;
constexpr int DH = 1024;
constexpr int NH = 8, HD = 128;
constexpr float EPS = 1e-6f;
constexpr float C2 = 0.08838834764831845f * 1.4426950408889634f;

constexpr size_t O_Y = 0;
constexpr size_t O_KP = (size_t)MT * DM;
constexpr size_t O_VP = O_KP + (size_t)MP * DH;
constexpr size_t O_CP = O_VP + (size_t)MP * DH;
constexpr size_t O_KS = O_CP + (size_t)NB * 2 * DH;
constexpr size_t O_VS = O_KS + (size_t)MS * DH;
constexpr size_t O_CS = O_VS + (size_t)MS * DH;
constexpr size_t O_END = O_CS + (size_t)DB * 2 * DH;

constexpr size_t MiB = 1u << 20;
constexpr size_t WS_CTL = 0, CTL_ZERO_BYTES = 1 * MiB;
constexpr size_t WS_WIN = 2 * MiB;
constexpr size_t WS_WOUT = 34 * MiB;
constexpr size_t WS_H = 42 * MiB;
constexpr size_t WS_Q = 78 * MiB, WS_K = 96 * MiB, WS_V = 114 * MiB, WS_GS = 132 * MiB, WS_CU = 150 * MiB, WS_BG = 168 * MiB;
constexpr size_t WS_MIX = 186 * MiB;
constexpr size_t WS_TMP = 224 * MiB;
constexpr size_t WS_END = 222 * MiB;

typedef unsigned short bf16;
#define GAS __attribute__((address_space(1)))
#define LAS __attribute__((address_space(3)))
#define NAIVE_P1 0
#define NAIVE_P2 0
#define NAIVE_P3 0
#define ONE_LAUNCH 1
namespace pg8 {
#define PG8_LAS __attribute__((address_space(3)))
typedef unsigned short bf16_t;
typedef short bf16x8 __attribute__((ext_vector_type(8)));
typedef float f32x4 __attribute__((ext_vector_type(4)));
typedef unsigned u32x4 __attribute__((ext_vector_type(4)));
constexpr int BM = 256, BK = 64, HALF = 128, HTB = HALF * BK * 2  , STAGE_BYTES = 8 * HTB, NXCD = 8, WGM = 8;

__host__ __device__ __forceinline__ int lds_byte(int r, int c) { const int st = (r >> 4) * 2 + (c >> 5), rr = r & 15, cc = c & 31, ob = rr * 64 + cc * 2; return st * 1024 + (ob ^ (((ob >> 9) & 1) << 5)); }
__host__ __device__ __forceinline__ void stage_rc(int b, int& R, int& C) { const int st = b / 1024, sb = b % 1024, swz = sb ^ (((sb >> 9) & 1) << 5); R = (st >> 1) * 16 + swz / 64; C = (st & 1) * 32 + (swz % 64) / 2; }
__host__ __device__ __forceinline__ int perm32(int rho) { const int n = rho >> 4, i = rho & 15; return 8 * (i >> 2) + 4 * n + (i & 3); }

struct Unit { int pm, pn; };
struct Gemm { const bf16_t* A; const bf16_t* Bt; int M, N, K; };

struct StaticOrder {
    int nM, nN, nwg, G, c;
    __host__ __device__ void init(int M, int N, int G_, int c_) { nM = M / BM; nN = N / BM; nwg = nM * nN; G = G_; c = c_; }
    __host__ __device__ bool next(int i, Unit& u) const {
        const long L = (long)i * G + c; if (L >= nwg) return false;
        int wgid = (int)L; { const int q = nwg / NXCD, r = nwg % NXCD, xcd = wgid % NXCD, off = wgid / NXCD; wgid = (xcd < r ? xcd * (q + 1) : r * (q + 1) + (xcd - r) * q) + off; }
        const int nig = WGM * nN, gid = wgid / nig, fm = gid * WGM, gsz = (nM - fm) < WGM ? (nM - fm) : WGM;
        u.pm = fm + ((wgid % nig) % gsz); u.pn = (wgid % nig) / gsz; return true;
    }
    __device__ __forceinline__ void a_ready(const Unit&) const {}
    __device__ __forceinline__ void done(const Unit&) const {}
};

typedef float f32x2_t __attribute__((ext_vector_type(2))); typedef __bf16 bf16x2_t __attribute__((ext_vector_type(2)));
__device__ __forceinline__ unsigned cvtpk(float lo, float hi) { f32x2_t v = {lo, hi}; bf16x2_t b = __builtin_convertvector(v, bf16x2_t); return __builtin_bit_cast(unsigned, b); }
__device__ __forceinline__ float silu_f(float x) { return x * __builtin_amdgcn_rcpf(1.0f + __builtin_amdgcn_exp2f(-1.4426950408889634f * x)); }
__device__ __forceinline__ f32x4 silu4(f32x4 v) { f32x4 o; o[0] = silu_f(v[0]); o[1] = silu_f(v[1]); o[2] = silu_f(v[2]); o[3] = silu_f(v[3]); return o; }

struct Epi1 {
    static constexpr bool PERM = true, AFTER_DRAIN = false;
    bf16_t *Qb, *Kb, *Vb, *Gs, *CU, *BG; float* out;
    __device__ __forceinline__ void operator()(const f32x4 (&acc)[2][2][4][2], const Unit& u, int wr, int wc, int fr, int fq) const {
        const int pn = u.pn, row0 = u.pm * BM + wr * 64 + fr, cl = wc * 32 + 8 * fq;
        if (pn < 16) {
            const int typ = pn >> 2, colb = (pn & 3) * 256 + cl;
            bf16_t* dst = typ == 0 ? Qb : (typ == 1 ? Kb : (typ == 2 ? Vb : Gs));
#pragma unroll
            for (int ai = 0; ai < 2; ++ai)
#pragma unroll
                for (int m = 0; m < 4; ++m) { const int row = row0 + ai * HALF + m * 16;
#pragma unroll
                    for (int bj = 0; bj < 2; ++bj) { const int col = colb + bj * HALF; f32x4 v0 = acc[ai][bj][m][0], v1 = acc[ai][bj][m][1];
                        if (typ == 0) { v0 = v0 * C2; v1 = v1 * C2; }
                        if (typ == 3) { v0 = silu4(v0); v1 = silu4(v1); }
                        if (typ == 1 || typ == 2) {
                            float* o = out + (row < MP ? (typ == 1 ? O_KP : O_VP) + (size_t)row * DH : (typ == 1 ? O_KS : O_VS) + (size_t)(row - MP) * DH) + col;
                            *(f32x4*)o = v0; *(f32x4*)(o + 4) = v1; }
                        u32x4 w; w.x = cvtpk(v0[0], v0[1]); w.y = cvtpk(v0[2], v0[3]); w.z = cvtpk(v1[0], v1[1]); w.w = cvtpk(v1[2], v1[3]);
                        *(u32x4*)(dst + (size_t)row * DH + col) = w; } }
        } else if (pn < 24) {
            const int chb = (pn - 16) * 128 + cl;
#pragma unroll
            for (int ai = 0; ai < 2; ++ai)
#pragma unroll
                for (int m = 0; m < 4; ++m) { const int row = row0 + ai * HALF + m * 16;
                    const f32x4 v0 = acc[ai][0][m][0] * acc[ai][1][m][0], v1 = acc[ai][0][m][1] * acc[ai][1][m][1];
                    u32x4 w; w.x = cvtpk(v0[0], v0[1]); w.y = cvtpk(v0[2], v0[3]); w.z = cvtpk(v1[0], v1[1]); w.w = cvtpk(v1[2], v1[3]);
                    *(u32x4*)(CU + (size_t)row * DH + chb) = w;
                    if (row < MP) { const int t = row & (SEQ - 1); if (t >= SEQ - 2) { float* o = out + O_CP + (size_t)((row >> 11) * 2 + (t - (SEQ - 2))) * DH + chb; *(f32x4*)o = v0; *(f32x4*)(o + 4) = v1; } }
                    else { const int r2 = row - MP, t = r2 & (DS - 1); if (t >= DS - 2) { float* o = out + O_CS + (size_t)((r2 >> 5) * 2 + (t - (DS - 2))) * DH + chb; *(f32x4*)o = v0; *(f32x4*)(o + 4) = v1; } } }
        } else {
            const int chb = (pn - 24) * 128 + cl;
#pragma unroll
            for (int ai = 0; ai < 2; ++ai)
#pragma unroll
                for (int m = 0; m < 4; ++m) { const int row = row0 + ai * HALF + m * 16;
                    const f32x4 v0 = acc[ai][0][m][0] * silu4(acc[ai][1][m][0]), v1 = acc[ai][0][m][1] * silu4(acc[ai][1][m][1]);
                    u32x4 w; w.x = cvtpk(v0[0], v0[1]); w.y = cvtpk(v0[2], v0[3]); w.z = cvtpk(v1[0], v1[1]); w.w = cvtpk(v1[2], v1[3]);
                    *(u32x4*)(BG + (size_t)row * DH + chb) = w; }
        }
    }
};
struct Epi2 {
    static constexpr bool PERM = false, AFTER_DRAIN = false;
    const float* xp; const float* xs; float* y;
    __device__ __forceinline__ void operator()(const f32x4 (&acc)[2][2][4][2], const Unit& u, int wr, int wc, int fr, int fq) const {
        const int row0 = u.pm * BM + wr * 64 + fr, col0 = u.pn * BM + wc * 32 + 4 * fq;
        const float* xb = u.pm < MP / BM ? xp + (size_t)row0 * DM : xs + (size_t)(row0 - MP) * DM; float* yb = y + (size_t)row0 * DM;
        f32x4 xr[2][2][2];
#define LDX(slot, g_) do { const int ai_ = (g_) >> 2, m_ = (g_) & 3; const float* xq = xb + (size_t)(ai_ * HALF + m_ * 16) * DM + col0; \
        _Pragma("unroll") for (int bj = 0; bj < 2; ++bj) _Pragma("unroll") for (int n = 0; n < 2; ++n) xr[slot][bj][n] = *(const f32x4*)(xq + bj * HALF + n * 16); } while (0)
        LDX(0, 0);
#pragma unroll
        for (int g = 0; g < 8; ++g) { const int ai = g >> 2, m = g & 3;
            if (g + 1 < 8) LDX((g + 1) & 1, g + 1);
            float* yq = yb + (size_t)(ai * HALF + m * 16) * DM + col0;
#pragma unroll
            for (int bj = 0; bj < 2; ++bj)
#pragma unroll
                for (int n = 0; n < 2; ++n) *(f32x4*)(yq + bj * HALF + n * 16) = acc[ai][bj][m][n] + xr[g & 1][bj][n]; }
#undef LDX
    }
};

struct OneUnit {
    int pm, pn; bool has;
    __device__ __forceinline__ bool next(int i, Unit& u) const { if (i > 0 || !has) return false; u.pm = pm; u.pn = pn; return true; }
    __device__ __forceinline__ void a_ready(const Unit&) const {}
    __device__ __forceinline__ void done(const Unit&) const {}
};

template <class Epi, class Sched, bool ALIGN_EPI = false, bool SP2 = false>
__device__ __forceinline__ void gemm_phase(PG8_LAS unsigned char* lds, const Gemm g, const Sched& S, const Epi& E) {
    const int tid = threadIdx.x, wid = __builtin_amdgcn_readfirstlane(tid >> 6), lane = tid & 63, wr = wid >> 2, wc = wid & 3, fr = lane & 15, fq = lane >> 4;
    const int K = g.K, nt = K / BK;
    unsigned voffA[2], voffB[2];
#pragma unroll
    for (int i = 0; i < 2; ++i) { int R, C; stage_rc(tid * 16 + i * 8192, R, C); const int Rb = Epi::PERM ? ((R & ~31) + perm32(R & 31)) : R;
        voffA[i] = (unsigned)(R * K + C) * 2u; voffB[i] = (unsigned)(Rb * K + C) * 2u; }
    const size_t kstep = (size_t)(BK * 2);
    const size_t hstep = (size_t)HALF * K * 2;
    const size_t tstep = 2 * hstep;
    const unsigned ldsw = (unsigned)wid * 1024u;
    const int aoff = lds_byte(wr * 64 + fr, fq * 8), boff = lds_byte(wc * 32 + fr, fq * 8);
#define PG8_SA(b, h) (((b) * 2 + (h)) * HTB)
#define PG8_SB(b, h) ((4 + (b) * 2 + (h)) * HTB)
#define PG8_STAGE(bufoff, gbase, voff) do { _Pragma("unroll") for (int _i = 0; _i < 2; ++_i) \
        __builtin_amdgcn_global_load_lds((const unsigned*)((const char*)(gbase) + (voff)[_i]), (PG8_LAS unsigned*)(lds + (bufoff) + ldsw + _i * 8192), 16, 0, 0); } while (0)
#define PG8_LDA(dst, b, h) do { _Pragma("unroll") for (int m = 0; m < 4; ++m) _Pragma("unroll") for (int k = 0; k < 2; ++k) dst[m][k] = *(const PG8_LAS bf16x8*)(lds + PG8_SA(b, h) + aoff + m * 2048 + k * 1024); } while (0)
#define PG8_LDB(dst, b, h) do { _Pragma("unroll") for (int n = 0; n < 2; ++n) _Pragma("unroll") for (int k = 0; k < 2; ++k) dst[n][k] = *(const PG8_LAS bf16x8*)(lds + PG8_SB(b, h) + boff + n * 2048 + k * 1024); } while (0)
#define PG8_MMA(ai, bj, At, Bt) do { __builtin_amdgcn_s_setprio(1); _Pragma("unroll") for (int m = 0; m < 4; ++m) _Pragma("unroll") for (int n = 0; n < 2; ++n) _Pragma("unroll") for (int k = 0; k < 2; ++k) \
        acc[ai][bj][m][n] = __builtin_amdgcn_mfma_f32_16x16x32_bf16(Bt[n][k], At[m][k], acc[ai][bj][m][n], 0, 0, 0); __builtin_amdgcn_s_setprio(0); } while (0)
#define PG8_WAIT_V(n) asm volatile("s_waitcnt vmcnt(" #n ")" ::: "memory")
#define PG8_WAIT_L(n) asm volatile("s_waitcnt lgkmcnt(" #n ")" ::: "memory")
#define PG8_BAR __builtin_amdgcn_s_barrier()
#define PG8_SCHED __builtin_amdgcn_sched_barrier(0)
    Unit cur, nxt; int ui = 0;
    if (!S.next(0, cur)) return;
    f32x4 acc[2][2][4][2];
#pragma unroll
    for (int a = 0; a < 2; ++a)
#pragma unroll
        for (int b = 0; b < 2; ++b)
#pragma unroll
            for (int m = 0; m < 4; ++m)
#pragma unroll
                for (int n = 0; n < 2; ++n) acc[a][b][m][n] = (f32x4){0.f, 0.f, 0.f, 0.f};
    bf16x8 At[4][2], B0[2][2], B1[2][2];
    const char* cA = (const char*)g.A + (size_t)cur.pm * tstep; const char* cB = (const char*)g.Bt + (size_t)cur.pn * tstep;
    S.a_ready(cur);
    if constexpr (SP2) {
        PG8_STAGE(PG8_SB(0, 0), cB, voffB); PG8_STAGE(PG8_SB(0, 1), cB + hstep, voffB); PG8_STAGE(PG8_SA(0, 0), cA, voffA); PG8_STAGE(PG8_SA(0, 1), cA + hstep, voffA);
        if (wr == 1) PG8_BAR;
        PG8_WAIT_V(2); PG8_BAR;
        PG8_STAGE(PG8_SB(1, 0), cB + kstep, voffB); PG8_STAGE(PG8_SA(1, 0), cA + kstep, voffA); PG8_STAGE(PG8_SB(1, 1), cB + hstep + kstep, voffB);
        PG8_WAIT_V(6); PG8_BAR;
    } else {
        PG8_STAGE(PG8_SB(0, 0), cB, voffB); PG8_STAGE(PG8_SA(0, 0), cA, voffA); PG8_STAGE(PG8_SB(0, 1), cB + hstep, voffB); PG8_STAGE(PG8_SA(0, 1), cA + hstep, voffA);
        if (wr == 1) PG8_BAR;
        PG8_WAIT_V(4); PG8_BAR;
        PG8_STAGE(PG8_SB(1, 0), cB + kstep, voffB); PG8_STAGE(PG8_SA(1, 0), cA + kstep, voffA); PG8_STAGE(PG8_SB(1, 1), cB + hstep + kstep, voffB);
        PG8_WAIT_V(6); PG8_BAR;
    }
    for (;;) {
        const bool has_next = S.next(ui + 1, nxt);
        const char* nA = has_next ? (const char*)g.A + (size_t)nxt.pm * tstep : cA; const char* nB = has_next ? (const char*)g.Bt + (size_t)nxt.pn * tstep : cB;
        for (int t = 0; t < nt; t += 2) {
            const bool last = (t == nt - 2);
            const char* a1 = cA + (size_t)(t + 1) * kstep;
            const char* a2 = last ? nA : cA + (size_t)(t + 2) * kstep; const char* b2 = last ? nB : cB + (size_t)(t + 2) * kstep;
            const char* a3 = a2 + kstep; const char* b3 = b2 + kstep;
            if (last && has_next) S.a_ready(nxt);
            if constexpr (SP2) {
            PG8_LDB(B0, 0, 0); PG8_LDB(B1, 0, 1); PG8_SCHED; PG8_LDA(At, 0, 0); PG8_STAGE(PG8_SA(1, 1), a1 + hstep, voffA);
            PG8_WAIT_V(8); PG8_WAIT_L(0); PG8_BAR; PG8_MMA(0, 0, At, B0); PG8_MMA(0, 1, At, B1); PG8_BAR; PG8_SCHED;
            PG8_LDA(At, 0, 1); PG8_STAGE(PG8_SB(0, 0), b2, voffB); PG8_STAGE(PG8_SB(0, 1), b2 + hstep, voffB); PG8_STAGE(PG8_SA(0, 0), a2, voffA);
            PG8_WAIT_V(8); PG8_WAIT_L(0); PG8_BAR; PG8_MMA(1, 0, At, B0); PG8_MMA(1, 1, At, B1); PG8_BAR; PG8_SCHED;
            PG8_LDB(B0, 1, 0); PG8_LDB(B1, 1, 1); PG8_SCHED; PG8_LDA(At, 1, 0); PG8_STAGE(PG8_SA(0, 1), a2 + hstep, voffA);
            PG8_WAIT_V(8); PG8_WAIT_L(0); PG8_BAR; PG8_MMA(0, 0, At, B0); PG8_MMA(0, 1, At, B1); PG8_BAR; PG8_SCHED;
            PG8_LDA(At, 1, 1); PG8_STAGE(PG8_SB(1, 0), b3, voffB); PG8_STAGE(PG8_SB(1, 1), b3 + hstep, voffB); PG8_STAGE(PG8_SA(1, 0), a3, voffA);
            PG8_WAIT_V(8); PG8_WAIT_L(0); PG8_BAR; PG8_MMA(1, 0, At, B0); PG8_MMA(1, 1, At, B1); PG8_BAR; PG8_SCHED;
            } else {
            PG8_LDB(B0, 0, 0); PG8_SCHED; PG8_LDA(At, 0, 0); PG8_STAGE(PG8_SA(1, 1), a1 + hstep, voffA);
            PG8_WAIT_L(8); PG8_BAR; PG8_WAIT_L(0); PG8_MMA(0, 0, At, B0); PG8_BAR; PG8_SCHED;
            PG8_LDB(B1, 0, 1); PG8_STAGE(PG8_SB(0, 0), b2, voffB);
            PG8_BAR; PG8_WAIT_L(0); PG8_MMA(0, 1, At, B1); PG8_BAR;
            PG8_LDA(At, 0, 1); PG8_STAGE(PG8_SA(0, 0), a2, voffA);
            PG8_BAR; PG8_WAIT_L(0); PG8_MMA(1, 0, At, B0); PG8_BAR; PG8_SCHED;
            PG8_STAGE(PG8_SB(0, 1), b2 + hstep, voffB);
            PG8_WAIT_V(6); PG8_BAR; PG8_MMA(1, 1, At, B1); PG8_BAR;
            PG8_LDB(B0, 1, 0); PG8_SCHED; PG8_LDA(At, 1, 0); PG8_STAGE(PG8_SA(0, 1), a2 + hstep, voffA);
            PG8_WAIT_L(8); PG8_BAR; PG8_WAIT_L(0); PG8_MMA(0, 0, At, B0); PG8_BAR; PG8_SCHED;
            PG8_LDB(B1, 1, 1); PG8_STAGE(PG8_SB(1, 0), b3, voffB);
            PG8_BAR; PG8_WAIT_L(0); PG8_MMA(0, 1, At, B1); PG8_BAR;
            PG8_LDA(At, 1, 1); PG8_STAGE(PG8_SA(1, 0), a3, voffA);
            PG8_BAR; PG8_WAIT_L(0); PG8_MMA(1, 0, At, B0); PG8_BAR; PG8_SCHED;
            PG8_STAGE(PG8_SB(1, 1), b3 + hstep, voffB);
            PG8_WAIT_V(6); PG8_BAR; PG8_MMA(1, 1, At, B1); PG8_BAR;
            }
        }
        if constexpr (ALIGN_EPI) { if (wr == 0) PG8_BAR; }
        if constexpr (!Epi::AFTER_DRAIN) { E(acc, cur, wr, wc, fr, fq); S.done(cur); }
        if (!has_next) break;
#pragma unroll
        for (int a = 0; a < 2; ++a)
#pragma unroll
            for (int b = 0; b < 2; ++b)
#pragma unroll
                for (int m = 0; m < 4; ++m)
#pragma unroll
                    for (int n = 0; n < 2; ++n) acc[a][b][m][n] = (f32x4){0.f, 0.f, 0.f, 0.f};
        cur = nxt; cA = nA; cB = nB; ++ui;
        if constexpr (ALIGN_EPI) { if (wr == 1) PG8_BAR; }
    }
    PG8_WAIT_V(0);
    if constexpr (!ALIGN_EPI) { if (wr == 0) PG8_BAR; }
    PG8_BAR;
    if constexpr (Epi::AFTER_DRAIN) { E.fused(acc, cur, wr, wc, fr, fq, lds, wid, lane); S.done(cur); }
#undef PG8_SA
#undef PG8_SB
#undef PG8_STAGE
#undef PG8_LDA
#undef PG8_LDB
#undef PG8_MMA
#undef PG8_WAIT_V
#undef PG8_WAIT_L
#undef PG8_BAR
#undef PG8_SCHED
}
}
constexpr int NWAVES = 8;
constexpr int RING_OFF = 0, RING_BYTES = 131072;
constexpr int LDSCTL_OFF = 155648, MISC_OFF = LDSCTL_OFF + 320;
constexpr int XCH_OFF = LDSCTL_OFF + 1024;
constexpr int LDS_BYTES = 159744;
static_assert(XCH_OFF + 1024 <= LDS_BYTES && MISC_OFF + 128 <= XCH_OFF, "LDS map");

typedef unsigned v4u __attribute__((ext_vector_type(4)));
typedef unsigned v2u __attribute__((ext_vector_type(2)));
typedef float f32x4 __attribute__((ext_vector_type(4)));
typedef short bf16x8 __attribute__((ext_vector_type(8)));
typedef short s16x4 __attribute__((ext_vector_type(4)));
typedef float f32x16 __attribute__((ext_vector_type(16)));
typedef GAS unsigned gu32;
#define RLX_AGENT __ATOMIC_RELAXED, __HIP_MEMORY_SCOPE_AGENT
#define LDS_WAIT() asm volatile("s_waitcnt lgkmcnt(0)" ::: "memory")
#define VM_WAIT() asm volatile("s_waitcnt vmcnt(0)" ::: "memory")
#define CFENCE() do { asm volatile("" ::: "memory"); __builtin_amdgcn_wave_barrier(); asm volatile("" ::: "memory"); } while (0)
using pg8::cvtpk;
__device__ __forceinline__ float bf2f(unsigned b) { return __uint_as_float(b << 16); }
__device__ __forceinline__ float bflo(unsigned w) { return __uint_as_float(w << 16); }
__device__ __forceinline__ float bfhi(unsigned w) { return __uint_as_float(w & 0xffff0000u); }

#define XB_TMO      128
#define XB_XCNT(j)  (256  + 64 * (j))
#define XB_XSUB(j)  (1280 + 64 * (j))
#define XB_XGEN(j)  (2304 + 64 * (j))
#define XB_TOP      3328
#define XB_TOPGEN   3392
#define XCD_BAR_WORDS 3456
#define XB_SPIN_CAP (1u << 18)

__device__ __forceinline__ unsigned xb_ld(unsigned* p)              { return __hip_atomic_load(p, __ATOMIC_RELAXED, __HIP_MEMORY_SCOPE_AGENT); }
__device__ __forceinline__ unsigned xb_add(unsigned* p, unsigned v) { return __hip_atomic_fetch_add(p, v, __ATOMIC_RELAXED, __HIP_MEMORY_SCOPE_AGENT); }
__device__ __forceinline__ unsigned xb_xcc_id() { return (unsigned)__builtin_amdgcn_s_getreg((3 << 11) | 20) & 0xFu; }
#define XB_SPIN(cond, bar) do { unsigned _sp = 0; while (cond) { __builtin_amdgcn_s_sleep(1); \
    if ((++_sp & 255u) == 0u) { if (xb_ld(&(bar)[XB_TMO])) break; if (_sp > XB_SPIN_CAP) { atomicAdd(&(bar)[XB_TMO], 1u); break; } } } } while (0)

struct XcdBarrier {
    unsigned* bar; unsigned x;
    volatile LAS unsigned* st;
};

__device__ __forceinline__ XcdBarrier xcd_barrier_post(unsigned* bar, volatile LAS unsigned* st) {
    XcdBarrier b; b.bar = bar; b.x = xb_xcc_id(); b.st = st;
    if (threadIdx.x == 0) (void)xb_add(&bar[XB_XCNT(b.x)], 1u);
    return b;
}
__device__ __forceinline__ void xcd_barrier_complete(unsigned* bar, unsigned x, unsigned& nloc, unsigned& nx) {
    const unsigned G = gridDim.x * gridDim.y * gridDim.z;
    unsigned sum, cnt, mine, sp = 0u;
    for (;;) {
        sum = 0u; cnt = 0u; mine = 0u;
#pragma unroll
        for (unsigned j = 0; j < 16; ++j) { const unsigned c = xb_ld(&bar[XB_XCNT(j)]); sum += c; cnt += (c > 0u) ? 1u : 0u; mine = (j == x) ? c : mine; }
        if (sum == G) break;
        __builtin_amdgcn_s_sleep(1);
        if ((++sp & 255u) == 0u) { if (xb_ld(&bar[XB_TMO])) break; if (sp > XB_SPIN_CAP) { atomicAdd(&bar[XB_TMO], 1u); break; } }
    }
    nloc = mine > 0u ? mine : 1u; nx = cnt > 0u ? cnt : 1u;
}

__device__ __forceinline__ void xcd_barrier(const XcdBarrier& b) {
    asm volatile("s_waitcnt vmcnt(0)" ::: "memory");
    __syncthreads();
    if (threadIdx.x == 0) {
        unsigned* bar = b.bar;
        __builtin_amdgcn_s_waitcnt(0);
        unsigned nloc = b.st[0], nx = b.st[1];
        if (nloc == 0u) { xcd_barrier_complete(bar, b.x, nloc, nx); b.st[0] = nloc; b.st[1] = nx; }
        const unsigned old = xb_add(&bar[XB_XSUB(b.x)], 1u);
        const unsigned gen = old / nloc;
        if (old + 1u == (gen + 1u) * nloc) {
            __builtin_amdgcn_fence(__ATOMIC_RELEASE, "agent");
            asm volatile("s_waitcnt vmcnt(0)" ::: "memory");
            const unsigned og = xb_add(&bar[XB_TOP], 1u);
            const unsigned tg = og / nx;
            if (og + 1u == (tg + 1u) * nx) xb_add(&bar[XB_TOPGEN], 1u);
            else XB_SPIN(xb_ld(&bar[XB_TOPGEN]) == tg, bar);
            __builtin_amdgcn_fence(__ATOMIC_ACQUIRE, "agent");
            xb_add(&bar[XB_XGEN(b.x)], 1u);
            asm volatile("s_waitcnt vmcnt(0)" ::: "memory");
        } else {
            XB_SPIN(xb_ld(&bar[XB_XGEN(b.x)]) == gen, bar);
            __builtin_amdgcn_fence(__ATOMIC_ACQUIRE, "agent");
            asm volatile("s_waitcnt vmcnt(0)" ::: "memory");
        }
    }
    __syncthreads();
}

struct Frame {
    LAS unsigned char* lds;
    volatile LAS unsigned* MISC;
    gu32* ctl;
    int wave;
    int vcu, G;
    const float *xp, *xs, *ck, *cv, *sconv, *norm_g, *w_in, *conv_w, *w_out, *final_g; float* out;
    bf16 *Win_t, *Wout_t, *H, *Qb, *Kb, *Vb, *Gs, *CU, *BG, *MIX;
};

__device__ __forceinline__ int fresh_lane() { int l; asm volatile("v_mbcnt_lo_u32_b32 %0, -1, 0\n\tv_mbcnt_hi_u32_b32 %0, -1, %0" : "=v"(l)); return l; }
__device__ __forceinline__ float wave_sum(float v) {
#pragma unroll
    for (int o = 1; o < 64; o <<= 1) v += __shfl_xor(v, o);
    return v;
}
__device__ __forceinline__ void p0_transpose_item(const float* W, int K, int N, bf16* WT, int k0, int n0, int drow0, LAS float* scr, int lane) {
    f32x4 v[8];
#pragma unroll
    for (int i = 0; i < 8; ++i) v[i] = *(const GAS f32x4*)(W + (size_t)(k0 + 8 * i + (lane >> 3)) * N + n0 + 4 * (lane & 7));
#pragma unroll
    for (int i = 0; i < 8; ++i) { LAS float* q = scr + (8 * i + (lane >> 3)) * 33 + 4 * (lane & 7); q[0] = v[i].x; q[1] = v[i].y; q[2] = v[i].z; q[3] = v[i].w; }
    LDS_WAIT(); CFENCE();
    const int c = lane & 7;
#pragma unroll
    for (int j = 0; j < 4; ++j) { const int n = (lane >> 3) + 8 * j; const LAS float* s = scr + (8 * c) * 33 + n;
        v4u o; o.x = cvtpk(s[0 * 33], s[1 * 33]); o.y = cvtpk(s[2 * 33], s[3 * 33]); o.z = cvtpk(s[4 * 33], s[5 * 33]); o.w = cvtpk(s[6 * 33], s[7 * 33]);
        *(GAS v4u*)(WT + (size_t)(drow0 + n) * K + k0 + 8 * c) = o; }
    LDS_WAIT(); CFENCE();
}
__device__ __forceinline__ int win_dest_row(int n) {
    if (n < 4096) return n;
    const int s = (n - 4096) >> 10, ch = (n - 4096) & 1023, j = ch >> 7, cc = ch & 127;
    const int tile = (s == 1 || s == 2) ? 16 + j : 24 + j, half = (s == 2 || s == 3) ? 128 : 0;
    return tile * 256 + half + cc;
}
template <int NR>
__device__ __forceinline__ void rms_rows_to_bf16(const float* const (&xrow)[NR], const float* g, bf16* const (&orow)[NR], int lane) {
    f32x4 v[NR][8]; float s[NR];
#pragma unroll
    for (int r = 0; r < NR; ++r) { const GAS f32x4* xr = (const GAS f32x4*)xrow[r] + lane;
#pragma unroll
        for (int j = 0; j < 8; ++j) v[r][j] = xr[64 * j]; }
    const GAS f32x4* gr = (const GAS f32x4*)g + lane;
#pragma unroll
    for (int r = 0; r < NR; ++r) { float a = 0.f;
#pragma unroll
        for (int j = 0; j < 8; ++j) a += (v[r][j].x * v[r][j].x + v[r][j].y * v[r][j].y) + (v[r][j].z * v[r][j].z + v[r][j].w * v[r][j].w);
        s[r] = 1.0f / sqrtf(wave_sum(a) * (1.f / DM) + EPS); }
#pragma unroll
    for (int j = 0; j < 8; ++j) { const f32x4 gg = gr[64 * j];
#pragma unroll
        for (int r = 0; r < NR; ++r) { v2u w; w.x = cvtpk((v[r][j].x * s[r]) * gg.x, (v[r][j].y * s[r]) * gg.y); w.y = cvtpk((v[r][j].z * s[r]) * gg.z, (v[r][j].w * s[r]) * gg.w);
            ((GAS v2u*)orow[r] + lane)[64 * j] = w; } }
}
__device__ __forceinline__ void p0_prologue(Frame& F) {
    LAS float* scr = (LAS float*)(F.lds + RING_OFF + F.wave * 16384);
    const int gw = F.vcu * NWAVES + F.wave, NGW = F.G * NWAVES, lane = fresh_lane();
    constexpr int I_IN = (DM / 64) * (DIN / 32), I_OUT = (DM / 64) * (DM / 32);
    for (int it = gw; it < I_IN + I_OUT; it += NGW) {
        if (it < I_IN) { const int kb = it / (DIN / 32), nb = it % (DIN / 32); p0_transpose_item(F.w_in, DM, DIN, F.Win_t, 64 * kb, 32 * nb, win_dest_row(32 * nb), scr, lane); }
        else { const int r = it - I_IN, kb = r / (DM / 32), nb = r % (DM / 32); p0_transpose_item(F.w_out, DM, DM, F.Wout_t, 64 * kb, 32 * nb, 32 * nb, scr, lane); }
    }
    for (int m = gw; m < MT; m += 2 * NGW) {
        const int m2 = m + NGW;
        if (m2 < MT) { const float* const xr[2] = {m < MP ? F.xp + (size_t)m * DM : F.xs + (size_t)(m - MP) * DM, m2 < MP ? F.xp + (size_t)m2 * DM : F.xs + (size_t)(m2 - MP) * DM};
            bf16* const orow[2] = {F.H + (size_t)m * DM, F.H + (size_t)m2 * DM}; rms_rows_to_bf16<2>(xr, F.norm_g, orow, lane); }
        else { const float* const xr[1] = {m < MP ? F.xp + (size_t)m * DM : F.xs + (size_t)(m - MP) * DM}; bf16* const orow[1] = {F.H + (size_t)m * DM}; rms_rows_to_bf16<1>(xr, F.norm_g, orow, lane); }
    }
}
__device__ __forceinline__ void final_norm_rows(Frame& F, int m0, int m1, int gw, int nw) {
    const int lane = fresh_lane();
    for (int m = m0 + gw; m < m1; m += nw) {
        GAS f32x4* yr = (GAS f32x4*)(F.out + O_Y + (size_t)m * DM) + lane; const GAS f32x4* gr = (const GAS f32x4*)F.final_g + lane;
        f32x4 v[8]; float s = 0.f;
#pragma unroll
        for (int j = 0; j < 8; ++j) { v[j] = yr[64 * j]; s += (v[j].x * v[j].x + v[j].y * v[j].y) + (v[j].z * v[j].z + v[j].w * v[j].w); }
        const float r = 1.0f / sqrtf(wave_sum(s) * (1.f / DM) + EPS);
#pragma unroll
        for (int j = 0; j < 8; ++j) { const f32x4 gg = gr[64 * j]; f32x4 o; o.x = (v[j].x * r) * gg.x; o.y = (v[j].y * r) * gg.y; o.z = (v[j].z * r) * gg.z; o.w = (v[j].w * r) * gg.w; yr[64 * j] = o; }
    }
}
__device__ __forceinline__ void unpack8(const v4u w, float (&f)[8]) { f[0] = bflo(w.x); f[1] = bfhi(w.x); f[2] = bflo(w.y); f[3] = bfhi(w.y); f[4] = bflo(w.z); f[5] = bfhi(w.z); f[6] = bflo(w.w); f[7] = bfhi(w.w); }
__device__ __forceinline__ void ld8f(const float* p, float (&f)[8]) { const f32x4 a = *(const GAS f32x4*)p, b = *(const GAS f32x4*)(p + 4); f[0] = a.x; f[1] = a.y; f[2] = a.z; f[3] = a.w; f[4] = b.x; f[5] = b.y; f[6] = b.z; f[7] = b.w; }
struct ConvIn { v4u c0, g, c1, c2; f32x4 s1a, s1b, s2a, s2b; };
__device__ __forceinline__ void conv_load(Frame& F, int row, int ch, ConvIn& I) {
    const bool samp = row >= MP; const int t = samp ? ((row - MP) & (DS - 1)) : (row & (SEQ - 1)); const int b = samp ? ((row - MP) >> 5) : 0;
    I.c0 = *(const GAS v4u*)(F.CU + (size_t)row * DH + ch); I.g = *(const GAS v4u*)(F.BG + (size_t)row * DH + ch);
    I.c1 = (v4u){0u, 0u, 0u, 0u}; I.c2 = I.c1; I.s1a = (f32x4){0.f, 0.f, 0.f, 0.f}; I.s1b = I.s1a; I.s2a = I.s1a; I.s2b = I.s1a;
    if (t >= 1) I.c1 = *(const GAS v4u*)(F.CU + (size_t)(row - 1) * DH + ch);
    else if (samp) { const float* p = F.sconv + (size_t)(b * 2 + 1) * DH + ch; I.s1a = *(const GAS f32x4*)p; I.s1b = *(const GAS f32x4*)(p + 4); }
    if (t >= 2) I.c2 = *(const GAS v4u*)(F.CU + (size_t)(row - 2) * DH + ch);
    else if (samp) { const float* p = F.sconv + (size_t)(b * 2 + t) * DH + ch; I.s2a = *(const GAS f32x4*)p; I.s2b = *(const GAS f32x4*)(p + 4); }
}
__device__ __forceinline__ void conv_store(Frame& F, int row, int ch, const ConvIn& I, const float (&w0)[8], const float (&w1)[8], const float (&w2)[8]) {
    float c0[8], c1[8], c2[8], g[8]; unpack8(I.c0, c0); unpack8(I.g, g); unpack8(I.c1, c1); unpack8(I.c2, c2);
    c1[0] += I.s1a.x; c1[1] += I.s1a.y; c1[2] += I.s1a.z; c1[3] += I.s1a.w; c1[4] += I.s1b.x; c1[5] += I.s1b.y; c1[6] += I.s1b.z; c1[7] += I.s1b.w;
    c2[0] += I.s2a.x; c2[1] += I.s2a.y; c2[2] += I.s2a.z; c2[3] += I.s2a.w; c2[4] += I.s2b.x; c2[5] += I.s2b.y; c2[6] += I.s2b.z; c2[7] += I.s2b.w;
    float o[8];
#pragma unroll
    for (int i = 0; i < 8; ++i) o[i] = g[i] * ((w0[i] * c2[i] + w1[i] * c1[i]) + w2[i] * c0[i]);
    v4u w; w.x = cvtpk(o[0], o[1]); w.y = cvtpk(o[2], o[3]); w.z = cvtpk(o[4], o[5]); w.w = cvtpk(o[6], o[7]);
    *(GAS v4u*)(F.MIX + (size_t)row * DM + DH + ch) = w;
}
__device__ __forceinline__ void p2_convmix(Frame& F) {
    const int gw = F.vcu * NWAVES + F.wave, NGW = F.G * NWAVES, lane = fresh_lane();
    const int ch = (gw & 1) * 512 + lane * 8;
    float w0[8], w1[8], w2[8]; ld8f(F.conv_w + ch, w0); ld8f(F.conv_w + DH + ch, w1); ld8f(F.conv_w + 2 * DH + ch, w2);
    for (int item = gw; item < MT * 2; item += 2 * NGW) {
        const int item2 = item + NGW; ConvIn A, B;
        conv_load(F, item >> 1, ch, A);
        if (item2 < MT * 2) conv_load(F, item2 >> 1, ch, B);
        conv_store(F, item >> 1, ch, A, w0, w1, w2);
        if (item2 < MT * 2) conv_store(F, item2 >> 1, ch, B, w0, w1, w2);
    }
}

__device__ __forceinline__ void skinny_gemm2(Frame& F) {
    constexpr int PITCH = 144, ASZ = 128 * PITCH, STG = ASZ + 64 * PITCH;
    const int tid = threadIdx.x, lane = fresh_lane(), r32 = lane & 31, hi = lane >> 5, wm = F.wave >> 1, wn = F.wave & 1;
    const int mt = F.vcu >> 5, nt = F.vcu & 31;
    const bf16* A = F.MIX + (size_t)(MP + 128 * mt) * DM; const bf16* B = F.Wout_t + (size_t)(64 * nt) * DM;
    LAS char* L = (LAS char*)F.lds;
    const int arow = tid >> 3, ach = tid & 7;
    const bf16* ga = A + (size_t)arow * DM + ach * 8; const bf16* gb = B + (size_t)arow * DM + ach * 8;
    const int la = arow * PITCH + ach * 16;
    v4u ra0, ra1, rb;
#define SK_LD(kt_) do { ra0 = *(const GAS v4u*)(ga + (kt_) * 64); ra1 = *(const GAS v4u*)(ga + (size_t)64 * DM + (kt_) * 64); rb = *(const GAS v4u*)(gb + (kt_) * 64); } while (0)
#define SK_ST(st_) do { LAS char* q = L + (st_) * STG; *(LAS v4u*)(q + la) = ra0; *(LAS v4u*)(q + la + 64 * PITCH) = ra1; *(LAS v4u*)(q + ASZ + la) = rb; } while (0)
    f32x16 acc;
#pragma unroll
    for (int i = 0; i < 16; ++i) acc[i] = 0.f;
    SK_LD(0); SK_ST(0); SK_LD(1);
    __syncthreads();
    const int fa = (32 * wm + r32) * PITCH + hi * 16, fb = ASZ + (32 * wn + r32) * PITCH + hi * 16;
    for (int kt = 0; kt < DM / 64; ++kt) {
        if (kt + 1 < DM / 64) SK_ST((kt + 1) & 1);
        if (kt + 2 < DM / 64) SK_LD(kt + 2);
        LAS const char* q = L + (kt & 1) * STG;
        bf16x8 af[4], bfr[4];
#pragma unroll
        for (int s2 = 0; s2 < 4; ++s2) { af[s2] = *(LAS const bf16x8*)(q + fa + 32 * s2); bfr[s2] = *(LAS const bf16x8*)(q + fb + 32 * s2); }
#pragma unroll
        for (int s2 = 0; s2 < 4; ++s2) acc = __builtin_amdgcn_mfma_f32_32x32x16_bf16(af[s2], bfr[s2], acc, 0, 0, 0);
        __syncthreads();
    }
#undef SK_LD
#undef SK_ST
    const int col = 64 * nt + 32 * wn + r32; const int rowb = 128 * mt + 32 * wm + 4 * hi;
    float xv[16];
#pragma unroll
    for (int i = 0; i < 16; ++i) xv[i] = F.xs[(size_t)(rowb + (i & 3) + 8 * (i >> 2)) * DM + col];
#pragma unroll
    for (int i = 0; i < 16; ++i) F.out[O_Y + (size_t)(MP + rowb + (i & 3) + 8 * (i >> 2)) * DM + col] = acc[i] + xv[i];
}

namespace sb {
constexpr float EXIT_THR = -160.0f;
constexpr int KST = 272, VST = 320;
constexpr int QIMG_OFF = 32 * VST;
constexpr int ATT_REGION = 19456;
static_assert(QIMG_OFF + 32 * KST <= ATT_REGION && 8 * ATT_REGION <= LDSCTL_OFF, "attention LDS map");
typedef __amdgpu_buffer_rsrc_t rsrc_t;
__device__ __forceinline__ rsrc_t mk_rsrc(const void* p, unsigned bytes) { return __builtin_amdgcn_make_buffer_rsrc((void*)p, (short)0, (int)bytes, 0x00020000); }
__device__ __forceinline__ int crow(int r, int hi) { return (r & 3) + 8 * (r >> 2) + 4 * hi; }
__device__ __forceinline__ s16x4 vtr(LAS const char* p) { typedef short v4i16_t __attribute__((ext_vector_type(4))); return __builtin_bit_cast(s16x4, __builtin_amdgcn_ds_read_tr16_b64_v4i16((LAS v4i16_t*)p)); }

__device__ __forceinline__ void ld_bf16(v4u (&R)[8], rsrc_t rs, int soff, int lane) {
    const int voff = ((lane >> 4) * DH + (lane & 15) * 8) * 2;
#pragma unroll
    for (int i = 0; i < 8; ++i) R[i] = __builtin_bit_cast(v4u, __builtin_amdgcn_raw_buffer_load_b128(rs, voff, soff + i * (4 * DH * 2), 0));
}
__device__ __forceinline__ void st_k_bf16(LAS char* img, const v4u (&R)[8], int lane) {
    LAS char* p = img + (lane >> 4) * KST + (lane & 15) * 16;
#pragma unroll
    for (int i = 0; i < 8; ++i) *(LAS v4u*)(p + i * 4 * KST) = R[i];
}
__device__ __forceinline__ void st_v_bf16(LAS char* img, const v4u (&R)[8], int lane) {
    LAS char* p = img + (lane >> 4) * VST + (lane & 15) * 16;
#pragma unroll
    for (int i = 0; i < 8; ++i) *(LAS v4u*)(p + i * 4 * VST) = R[i];
}
__device__ __forceinline__ void ld_f32(f32x4 (&R)[16], rsrc_t rs, int soff, int lane) {
    const int voff = ((lane >> 5) * DH + (lane & 31) * 4) * 4;
#pragma unroll
    for (int i = 0; i < 16; ++i) R[i] = __builtin_bit_cast(f32x4, __builtin_amdgcn_raw_buffer_load_b128(rs, voff, soff + i * (2 * DH * 4), 0));
}
__device__ __forceinline__ void st_k_f32(LAS char* img, const f32x4 (&R)[16], int lane) {
    LAS char* p = img + (lane >> 5) * KST + (lane & 31) * 8;
#pragma unroll
    for (int i = 0; i < 16; ++i) { v2u w; w.x = cvtpk(R[i].x, R[i].y); w.y = cvtpk(R[i].z, R[i].w); *(LAS v2u*)(p + i * 2 * KST) = w; }
}
__device__ __forceinline__ void st_v_f32(LAS char* img, const f32x4 (&R)[16], int lane) {
    LAS char* p = img + (lane >> 5) * VST + (lane & 31) * 8;
#pragma unroll
    for (int i = 0; i < 16; ++i) { v2u w; w.x = cvtpk(R[i].x, R[i].y); w.y = cvtpk(R[i].z, R[i].w); *(LAS v2u*)(p + i * 2 * VST) = w; }
}
template <bool MASK>
__device__ __forceinline__ void sb_weights(const f32x16& st, float& run, bf16x8& wf0, bf16x8& wf1, int r32, int hi) {
    float lb[16], ex[16], T[4];
#pragma unroll
    for (int i = 0; i < 16; ++i) { const float z = st[i]; const float e = __builtin_amdgcn_exp2f(-__builtin_fabsf(z)); const float lp = __builtin_amdgcn_logf(1.0f + e);
        float a = __builtin_fminf(z, 0.f) - lp, l1 = __builtin_fminf(-z, 0.f) - lp;
        if (MASK) { if (crow(i, hi) >= r32) { a = -INFINITY; l1 = 0.f; } }
        lb[i] = a; ex[i] = l1; }
#pragma unroll
    for (int g = 0; g < 4; ++g) { const float l0 = ex[4 * g], l1 = ex[4 * g + 1], l2 = ex[4 * g + 2], l3 = ex[4 * g + 3];
        ex[4 * g + 3] = 0.f; ex[4 * g + 2] = l3; ex[4 * g + 1] = l3 + l2; ex[4 * g] = (l3 + l2) + l1; T[g] = ((l3 + l2) + l1) + l0; }
    float P[4], U[4];
#pragma unroll
    for (int g = 0; g < 4; ++g) { P[g] = __shfl_xor(T[g], 32); U[g] = T[g] + P[g]; }
    const float A2 = U[3], A1 = U[3] + U[2], A0 = A1 + U[1], tot = A0 + U[0];
    float off[4]; off[3] = run; off[2] = run + A2; off[1] = run + A1; off[0] = run + A0;
    if (hi == 0) {
#pragma unroll
        for (int g = 0; g < 4; ++g) off[g] += P[g]; }
    float w[16];
#pragma unroll
    for (int i = 0; i < 16; ++i) w[i] = __builtin_amdgcn_exp2f(lb[i] + (off[i >> 2] + ex[i]));
    run += tot;
    v4u a, b; a.x = cvtpk(w[0], w[1]); a.y = cvtpk(w[2], w[3]); a.z = cvtpk(w[4], w[5]); a.w = cvtpk(w[6], w[7]);
    b.x = cvtpk(w[8], w[9]); b.y = cvtpk(w[10], w[11]); b.z = cvtpk(w[12], w[13]); b.w = cvtpk(w[14], w[15]);
    wf0 = __builtin_bit_cast(bf16x8, a); wf1 = __builtin_bit_cast(bf16x8, b);
}
template <bool MASK>
__device__ __forceinline__ void s_part(LAS const char* img, LAS const char* Qimg, float& run, bf16x8& wf0, bf16x8& wf1, int r32, int hi) {
    f32x16 st;
#pragma unroll
    for (int i = 0; i < 16; ++i) st[i] = 0.f;
    const int fo = r32 * KST + hi * 16;
#pragma unroll
    for (int s = 0; s < 8; ++s) { const bf16x8 kf = *(LAS const bf16x8*)(img + fo + 32 * s), qf = *(LAS const bf16x8*)(Qimg + fo + 32 * s); st = __builtin_amdgcn_mfma_f32_32x32x16_bf16(kf, qf, st, 0, 0, 0); }
    sb_weights<MASK>(st, run, wf0, wf1, r32, hi);
}
__device__ __forceinline__ void pv_part(LAS const char* img, f32x16 (&o)[4], const bf16x8 wf0, const bf16x8 wf1, int lane) {
    const int i = lane & 15, q4 = i >> 2, p = i & 3, hi = lane >> 5;
    LAS const char* vb = img + (4 * hi + q4) * VST + 32 * ((lane >> 4) & 1) + 8 * p;
#pragma unroll
    for (int dblk = 0; dblk < 4; ++dblk)
#pragma unroll
        for (int s = 0; s < 2; ++s) {
            const s16x4 lo = vtr(vb + 16 * s * VST + 64 * dblk), hh = vtr(vb + (16 * s + 8) * VST + 64 * dblk);
            const bf16x8 vf = (bf16x8){lo[0], lo[1], lo[2], lo[3], hh[0], hh[1], hh[2], hh[3]};
            o[dblk] = __builtin_amdgcn_mfma_f32_32x32x16_bf16(vf, s ? wf1 : wf0, o[dblk], 0, 0, 0); }
}
__device__ __forceinline__ void vfrag_load(LAS const char* img, bf16x8 (&vf)[8], int lane) {
    const int i = lane & 15, q4 = i >> 2, p = i & 3, hi = lane >> 5;
    LAS const char* vb = img + (4 * hi + q4) * VST + 32 * ((lane >> 4) & 1) + 8 * p;
#pragma unroll
    for (int dblk = 0; dblk < 4; ++dblk)
#pragma unroll
        for (int s = 0; s < 2; ++s) {
            const s16x4 lo = vtr(vb + 16 * s * VST + 64 * dblk), hh = vtr(vb + (16 * s + 8) * VST + 64 * dblk);
            vf[dblk * 2 + s] = (bf16x8){lo[0], lo[1], lo[2], lo[3], hh[0], hh[1], hh[2], hh[3]}; }
}
__device__ __forceinline__ void pv_mfma(const bf16x8 (&vf)[8], f32x16 (&o)[4], const bf16x8 wf0, const bf16x8 wf1) {
#pragma unroll
    for (int dblk = 0; dblk < 4; ++dblk) { o[dblk] = __builtin_amdgcn_mfma_f32_32x32x16_bf16(vf[dblk * 2], wf0, o[dblk], 0, 0, 0); o[dblk] = __builtin_amdgcn_mfma_f32_32x32x16_bf16(vf[dblk * 2 + 1], wf1, o[dblk], 0, 0, 0); }
}
template <bool MASK>
__device__ __forceinline__ void tile_bf16(v4u (&R)[8], rsrc_t rk, rsrc_t rv, int vo, int kno, f32x16 (&o)[4], float& run, LAS char* img, LAS char* Qimg, int lane) {
    st_k_bf16(img, R, lane);
    ld_bf16(R, rv, vo, lane);
    CFENCE();
    bf16x8 wf0, wf1;
    s_part<MASK>(img, Qimg, run, wf0, wf1, lane & 31, lane >> 5);
    CFENCE();
    st_v_bf16(img, R, lane);
    ld_bf16(R, rk, kno, lane);
    CFENCE();
    { bf16x8 vf[8]; vfrag_load(img, vf, lane); pv_mfma(vf, o, wf0, wf1); }
    CFENCE();
}
template <bool EARLY>
__device__ __forceinline__ void range_bf16(rsrc_t rk, rsrc_t rv, int off0, int tau_hi, int tau_lo, bool first_masked, f32x16 (&o)[4], float& run, LAS char* img, LAS char* Qimg, int lane) {
    if (tau_hi < tau_lo) return;
    constexpr int TB = 32 * DH * 2;
    v4u R[8];
    ld_bf16(R, rk, off0 + tau_hi * TB, lane);
    int tau = tau_hi;
    if (first_masked) { tile_bf16<true>(R, rk, rv, off0 + tau * TB, off0 + (tau > tau_lo ? tau - 1 : tau) * TB, o, run, img, Qimg, lane); --tau; }
    for (; tau >= tau_lo; --tau) {
        tile_bf16<false>(R, rk, rv, off0 + tau * TB, off0 + (tau > tau_lo ? tau - 1 : tau) * TB, o, run, img, Qimg, lane);
        if (EARLY) { if (__all(run < EXIT_THR)) break; }
    }
}
__device__ __forceinline__ void tile_f32(f32x4 (&R)[16], rsrc_t rk, rsrc_t rv, int vo, int kno, f32x16 (&o)[4], float& run, LAS char* img, LAS char* Qimg, int lane) {
    st_k_f32(img, R, lane);
    ld_f32(R, rv, vo, lane);
    CFENCE();
    bf16x8 wf0, wf1;
    s_part<false>(img, Qimg, run, wf0, wf1, lane & 31, lane >> 5);
    CFENCE();
    st_v_f32(img, R, lane);
    ld_f32(R, rk, kno, lane);
    CFENCE();
    { bf16x8 vf[8]; vfrag_load(img, vf, lane); pv_mfma(vf, o, wf0, wf1); }
    CFENCE();
}
template <bool EARLY>
__device__ __forceinline__ void range_f32(rsrc_t rk, rsrc_t rv, int off0, int tau_hi, int tau_lo, f32x16 (&o)[4], float& run, LAS char* img, LAS char* Qimg, int lane) {
    if (tau_hi < tau_lo) return;
    constexpr int TB = 32 * DH * 4;
    f32x4 R[16];
    ld_f32(R, rk, off0 + tau_hi * TB, lane);
    for (int tau = tau_hi; tau >= tau_lo; --tau) {
        tile_f32(R, rk, rv, off0 + tau * TB, off0 + (tau > tau_lo ? tau - 1 : tau) * TB, o, run, img, Qimg, lane);
        if (EARLY) { if (__all(run < EXIT_THR)) break; }
    }
}
__device__ __forceinline__ void load_q(LAS char* Qimg, rsrc_t rq, int soff  , int lane) {
    v4u R[8]; ld_bf16(R, rq, soff, lane); st_k_bf16(Qimg, R, lane); CFENCE();
}
__device__ __forceinline__ void zero_o(f32x16 (&o)[4]) {
#pragma unroll
    for (int d = 0; d < 4; ++d)
#pragma unroll
        for (int i = 0; i < 16; ++i) o[d][i] = 0.f;
}
__device__ __forceinline__ void epi_store(const f32x16 (&o)[4], const bf16* Gs_row, bf16* MIX_row, int hi) {
    v2u gg[16];
#pragma unroll
    for (int dblk = 0; dblk < 4; ++dblk)
#pragma unroll
        for (int g = 0; g < 4; ++g) gg[dblk * 4 + g] = *(const GAS v2u*)(Gs_row + 32 * dblk + 8 * g + 4 * hi);
#pragma unroll
    for (int dblk = 0; dblk < 4; ++dblk)
#pragma unroll
        for (int g = 0; g < 4; ++g) { const int d0 = 32 * dblk + 8 * g + 4 * hi; const v2u q = gg[dblk * 4 + g];
            v2u w; w.x = cvtpk(o[dblk][4 * g] * bflo(q.x), o[dblk][4 * g + 1] * bfhi(q.x)); w.y = cvtpk(o[dblk][4 * g + 2] * bflo(q.y), o[dblk][4 * g + 3] * bfhi(q.y));
            *(GAS v2u*)(MIX_row + d0) = w; }
}
struct Ctx { const bf16 *Qb, *Kb, *Vb, *Gs; bf16* MIX; const float *ck, *cv; };

__device__ __forceinline__ void ldq(v4u (&S)[2], rsrc_t rs, int soff, int wq, int lane) {
    const int voff = ((8 * wq + (lane >> 4)) * DH + (lane & 15) * 8) * 2;
    S[0] = __builtin_bit_cast(v4u, __builtin_amdgcn_raw_buffer_load_b128(rs, voff, soff, 0));
    S[1] = __builtin_bit_cast(v4u, __builtin_amdgcn_raw_buffer_load_b128(rs, voff, soff + 4 * DH * 2, 0));
}
__device__ __forceinline__ void stq(LAS char* img, int pitch, const v4u (&S)[2], int wq, int lane) {
    LAS char* p = img + (8 * wq + (lane >> 4)) * pitch + (lane & 15) * 16;
    *(LAS v4u*)p = S[0]; *(LAS v4u*)(p + 4 * pitch) = S[1];
}
__device__ __forceinline__ void sb_weights_rt(const f32x16& st, float& run, bf16x8& wf0, bf16x8& wf1, int r32, int hi, bool diag) {
    float lb[16], ex[16], T[4];
#pragma unroll
    for (int i = 0; i < 16; ++i) { const float z = st[i]; const float e = __builtin_amdgcn_exp2f(-__builtin_fabsf(z)); const float lp = __builtin_amdgcn_logf(1.0f + e);
        const float a = __builtin_fminf(z, 0.f) - lp; lb[i] = a; ex[i] = a - z; }
    if (diag) {
#pragma unroll
        for (int i = 0; i < 16; ++i) { const bool m = crow(i, hi) >= r32; lb[i] = m ? -INFINITY : lb[i]; ex[i] = m ? 0.f : ex[i]; } }
#pragma unroll
    for (int g = 0; g < 4; ++g) { const float l0 = ex[4 * g], l1 = ex[4 * g + 1], l2 = ex[4 * g + 2], l3 = ex[4 * g + 3];
        ex[4 * g + 3] = 0.f; ex[4 * g + 2] = l3; ex[4 * g + 1] = l3 + l2; ex[4 * g] = (l3 + l2) + l1; T[g] = ((l3 + l2) + l1) + l0; }
    float P[4], U[4];
#pragma unroll
    for (int g = 0; g < 4; ++g) { P[g] = __shfl_xor(T[g], 32); U[g] = T[g] + P[g]; }
    const float A2 = U[3], A1 = U[3] + U[2], A0 = A1 + U[1], tot = A0 + U[0];
    float off[4]; off[3] = run; off[2] = run + A2; off[1] = run + A1; off[0] = run + A0;
    if (hi == 0) {
#pragma unroll
        for (int g = 0; g < 4; ++g) off[g] += P[g]; }
    float w[16];
#pragma unroll
    for (int i = 0; i < 16; ++i) w[i] = __builtin_amdgcn_exp2f(lb[i] + (off[i >> 2] + ex[i]));
    run += tot;
    v4u a, b; a.x = cvtpk(w[0], w[1]); a.y = cvtpk(w[2], w[3]); a.z = cvtpk(w[4], w[5]); a.w = cvtpk(w[6], w[7]);
    b.x = cvtpk(w[8], w[9]); b.y = cvtpk(w[10], w[11]); b.z = cvtpk(w[12], w[13]); b.w = cvtpk(w[14], w[15]);
    wf0 = __builtin_bit_cast(bf16x8, a); wf1 = __builtin_bit_cast(bf16x8, b);
}
__device__ __forceinline__ void tile_q(LAS const char* img, LAS const char* vimg, const bf16x8 (&qf)[8], f32x16 (&o)[4], float& run, int lane, bool diag) {
    const int r32 = lane & 31, hi = lane >> 5; bf16x8 wf0, wf1;
    const int fo = r32 * KST + hi * 16;
    bf16x8 kf[8];
#pragma unroll
    for (int s = 0; s < 8; ++s) kf[s] = *(LAS const bf16x8*)(img + fo + 32 * s);
    __builtin_amdgcn_sched_barrier(0);
    f32x16 st;
#pragma unroll
    for (int i = 0; i < 16; ++i) st[i] = 0.f;
#pragma unroll
    for (int s = 0; s < 8; ++s) st = __builtin_amdgcn_mfma_f32_32x32x16_bf16(kf[s], qf[s], st, 0, 0, 0);
    bf16x8 vf[8]; vfrag_load(vimg, vf, lane);
    __builtin_amdgcn_sched_barrier(0);
    sb_weights_rt(st, run, wf0, wf1, r32, hi, diag);
    __builtin_amdgcn_sched_barrier(0);
    pv_mfma(vf, o, wf0, wf1);
}
__device__ __forceinline__ void load_qf(bf16x8 (&qf)[8], const bf16* Qrow, int hi) {
#pragma unroll
    for (int s = 0; s < 8; ++s) qf[s] = *(const GAS bf16x8*)(Qrow + 16 * s + 8 * hi);
#pragma unroll
    for (int s = 0; s < 8; ++s) asm volatile("" : "+v"(qf[s]));
}
constexpr int PG_BYTES = 2 * 32 * KST + 2 * 32 * VST;
static_assert(2 * PG_BYTES <= LDSCTL_OFF && 4 * 16384 <= 2 * PG_BYTES, "prompt LDS map");

template <bool EARLY, int ABL = 0>
__device__ __forceinline__ void prompt_unit(LAS unsigned char* lds, const Ctx& C, rsrc_t rK, rsrc_t rV, int unit, int wave, int lane) {
    const int r32 = lane & 31, hi = lane >> 5, grp = wave >> 2, wq = wave & 3;
    const int bh = unit >> 3, b = bh >> 3, h = bh & 7, j = unit & 7, B = 15 - j, nA = 4 * j + 4;
    const int s0 = (b * SEQ * DH + h * HD) * 2; constexpr int TB = 32 * DH * 2;
    LAS char* gb = (LAS char*)lds + grp * PG_BYTES;
    LAS float* xch = (LAS float*)((LAS char*)lds + XCH_OFF);
#define KT_OF(n) (grp ? (4 * B + 3 - (n)) : ((n) < nA ? (nA - 1 - (n)) : (29 - 4 * j - ((n) - nA))))
#define KBUF(i) (gb + (i) * (32 * KST))
#define VBUF(i) (gb + 2 * 32 * KST + (i) * (32 * VST))
    int X = grp ? B : j, qt = 4 * X + wq;
    bf16x8 qf[8]; load_qf(qf, C.Qb + ((size_t)b * SEQ + 32 * qt + r32) * DH + h * HD, hi);
    f32x16 o[4]; zero_o(o); float run = 0.f;
    v4u KA[2], VA[2], KB2[2], VB2[2];
#define LDT(KR, VR, n_) do { const int kt_ = KT_OF(n_); ldq(KR, rK, s0 + kt_ * TB, wq, lane); ldq(VR, rV, s0 + kt_ * TB, wq, lane); } while (0)
#define STT(KR, VR, n_) do { stq(KBUF((n_) & 1), KST, KR, wq, lane); stq(VBUF((n_) & 1), VST, VR, wq, lane); } while (0)
#define STEP(n_, KR, VR) do { const int n = (n_); \
        if (n + 1 < 34 && !(ABL & 4)) STT(KR, VR, n + 1); \
        if (n + 3 < 34 && !(ABL & 4)) LDT(KR, VR, n + 3); \
        if (grp == 0 && n == nA) { const size_t qrow = (size_t)b * SEQ + 32 * qt + r32; if (!(ABL & 2)) epi_store(o, C.Gs + qrow * DH + h * HD, C.MIX + qrow * DM + h * HD, hi); \
            X = B; qt = 4 * X + wq; load_qf(qf, C.Qb + ((size_t)b * SEQ + 32 * qt + r32) * DH + h * HD, hi); zero_o(o); run = 0.f; } \
        const int kt = KT_OF(n); bool live = kt <= qt; \
        if (EARLY) { if (__all(run < EXIT_THR)) live = false; } \
        if (live && !(ABL & 1)) tile_q(KBUF(n & 1), VBUF(n & 1), qf, o, run, lane, kt == qt); \
        __syncthreads(); } while (0)
    LDT(KB2, VB2, 0); STT(KB2, VB2, 0);
    LDT(KA, VA, 1); LDT(KB2, VB2, 2);
    __syncthreads();
    for (int n2 = 0; n2 < 34; n2 += 2) { STEP(n2, KA, VA); STEP(n2 + 1, KB2, VB2); }
#undef LDT
#undef STT
#undef STEP
    if (grp == 1 && hi == 0) xch[wq * 32 + r32] = run;
    __syncthreads();
    LAS float* rg = (LAS float*)((LAS char*)lds + wq * 16384);
    if (grp == 0) {
        const float f = __builtin_amdgcn_exp2f(xch[wq * 32 + r32]);
#pragma unroll
        for (int d = 0; d < 4; ++d)
#pragma unroll
            for (int k = 0; k < 16; ++k) rg[(d * 16 + k) * 64 + lane] = o[d][k] * f;
    }
    __syncthreads();
    if (grp == 1) {
#pragma unroll
        for (int d = 0; d < 4; ++d)
#pragma unroll
            for (int k = 0; k < 16; ++k) o[d][k] += rg[(d * 16 + k) * 64 + lane];
        const size_t qrow = (size_t)b * SEQ + 32 * qt + r32;
        if (!(ABL & 2)) epi_store(o, C.Gs + qrow * DH + h * HD, C.MIX + qrow * DM + h * HD, hi);
        else if (o[0][0] == 123.456f) C.MIX[qrow * DM] = 0;
    }
    __syncthreads();
#undef KT_OF
#undef KBUF
#undef VBUF
}
template <bool EARLY>
__device__ __forceinline__ void sample_unit(LAS unsigned char* lds, const Ctx& C, rsrc_t rQ, rsrc_t rK, rsrc_t rV, rsrc_t rCK, rsrc_t rCV, int unit, int wave, int lane) {
    LAS char* region = (LAS char*)lds + wave * ATT_REGION; LAS char* img = region; LAS char* Qimg = region + QIMG_OFF;
    LAS float* xch = (LAS float*)((LAS char*)lds + XCH_OFF);
    const int r32 = lane & 31, hi = lane >> 5;
    const int b = unit >> 3, h = unit & 7; const size_t qrow = (size_t)MP + 32 * b + r32;
    const int new0 = ((MP + 32 * b) * DH + h * HD) * 2;
    const int c0 = (b * PAST * DH + h * HD) * 4;
    load_q(Qimg, rQ, new0, lane);
    f32x16 o[4]; zero_o(o); float run = 0.f;
    if (wave == 7) {
        range_bf16<false>(rK, rV, new0, 0, 0, true, o, run, img, Qimg, lane);
        range_f32<EARLY>(rCK, rCV, c0, 31, 28, o, run, img, Qimg, lane);
    } else range_f32<EARLY>(rCK, rCV, c0, 4 * wave + 3, 4 * wave, o, run, img, Qimg, lane);
    if (hi == 0) xch[wave * 32 + r32] = run;
    __syncthreads();
    float fs = 0.f;
    for (int w2 = wave + 1; w2 < 8; ++w2) fs += xch[w2 * 32 + r32];
    const float f = __builtin_amdgcn_exp2f(fs);
    LAS float* rg = (LAS float*)region;
#pragma unroll
    for (int d = 0; d < 4; ++d)
#pragma unroll
        for (int i = 0; i < 16; ++i) rg[(d * 16 + i) * 64 + lane] = o[d][i] * f;
    __syncthreads();
    float res[8];
#pragma unroll
    for (int jx = 0; jx < 8; ++jx) { float s = 0.f;
#pragma unroll
        for (int w2 = 0; w2 < 8; ++w2) s += ((LAS const float*)((LAS const char*)lds + w2 * ATT_REGION))[(8 * wave + jx) * 64 + lane];
        res[jx] = s; }
    const bf16* Gs_row = C.Gs + qrow * DH + h * HD; bf16* MIX_row = C.MIX + qrow * DM + h * HD;
    v2u gq[2];
#pragma unroll
    for (int jj = 0; jj < 2; ++jj) gq[jj] = *(const GAS v2u*)(Gs_row + 32 * (wave >> 1) + 8 * (2 * (wave & 1) + jj) + 4 * hi);
#pragma unroll
    for (int jj = 0; jj < 2; ++jj) { const int d0 = 32 * (wave >> 1) + 8 * (2 * (wave & 1) + jj) + 4 * hi; const v2u gg = gq[jj];
        v2u w; w.x = cvtpk(res[4 * jj] * bflo(gg.x), res[4 * jj + 1] * bfhi(gg.x)); w.y = cvtpk(res[4 * jj + 2] * bflo(gg.y), res[4 * jj + 3] * bfhi(gg.y));
        *(GAS v2u*)(MIX_row + d0) = w; }
    __syncthreads();
}
template <bool EARLY, int ABL = 0>
__device__ __forceinline__ void attn_phase(LAS unsigned char* lds, const Ctx& C, int vcu, int parts  , int wave, int lane) {
    const rsrc_t rQ = mk_rsrc(C.Qb, (unsigned)MT * DH * 2), rK = mk_rsrc(C.Kb, (unsigned)MT * DH * 2), rV = mk_rsrc(C.Vb, (unsigned)MT * DH * 2);
    const rsrc_t rCK = mk_rsrc(C.ck, (unsigned)DB * PAST * DH * 4), rCV = mk_rsrc(C.cv, (unsigned)DB * PAST * DH * 4);
    const int unit = vcu;
    if (unit < 256)
        for (int part = 0; part < 2; ++part) {
            if ((part ^ unit) & 1) { if (parts & 2) prompt_unit<EARLY, ABL>(lds, C, rK, rV, unit, wave, lane); }
            else { if (parts & 1) sample_unit<EARLY>(lds, C, rQ, rK, rV, rCK, rCV, unit, wave, lane); }
        }
}
}

struct Args { const float* in[10]; float* out; unsigned char* ws; int ph_mask; int pad; };
#ifndef SB_EARLY
#define SB_EARLY false
#endif
__global__ void __launch_bounds__(NWAVES * 64, 2) mk_fwd(Args args) {
    extern __shared__ __attribute__((aligned(16))) unsigned char lds[];
    Frame F;
    F.lds = (LAS unsigned char*)lds;
    F.MISC = (volatile LAS unsigned*)(F.lds + MISC_OFF);
    F.wave = __builtin_amdgcn_readfirstlane(threadIdx.x >> 6);
    F.G = gridDim.x; { const int bx = blockIdx.x; F.vcu = (F.G % 8 == 0) ? (bx % 8) * (F.G / 8) + bx / 8 : bx; }
    unsigned char* ws = args.ws;
    F.ctl = (gu32*)(ws + WS_CTL);
    F.xp = args.in[0]; F.xs = args.in[1]; F.ck = args.in[2]; F.cv = args.in[3]; F.sconv = args.in[4]; F.norm_g = args.in[5]; F.w_in = args.in[6]; F.conv_w = args.in[7]; F.w_out = args.in[8]; F.final_g = args.in[9];
    F.out = args.out;
    F.Win_t = (bf16*)(ws + WS_WIN); F.Wout_t = (bf16*)(ws + WS_WOUT); F.H = (bf16*)(ws + WS_H); F.Qb = (bf16*)(ws + WS_Q); F.Kb = (bf16*)(ws + WS_K); F.Vb = (bf16*)(ws + WS_V);
    F.Gs = (bf16*)(ws + WS_GS); F.CU = (bf16*)(ws + WS_CU); F.BG = (bf16*)(ws + WS_BG); F.MIX = (bf16*)(ws + WS_MIX);
    for (int u = threadIdx.x; u < (LDS_BYTES - LDSCTL_OFF) / 4; u += NWAVES * 64) ((LAS unsigned*)(F.lds + LDSCTL_OFF))[u] = 0u;
    __syncthreads();
#if defined(PROBE_TS)
#define STAMP(i) do { if (blockIdx.x == 0 && threadIdx.x == 0) { const unsigned long long t_ = __builtin_amdgcn_s_memrealtime(); ((volatile LAS unsigned*)(F.lds + LDSCTL_OFF + 2048))[2 * (i)] = (unsigned)t_; ((volatile LAS unsigned*)(F.lds + LDSCTL_OFF + 2048))[2 * (i) + 1] = (unsigned)(t_ >> 32); } } while (0)
#else
#define STAMP(i) do {} while (0)
#endif
    STAMP(0);
    const int pm = args.ph_mask;
    const bool multi = (pm & (pm - 1)) != 0 && pm != 12;
    XcdBarrier bar; bar.bar = (unsigned*)(F.ctl + 4096); bar.x = 0; bar.st = nullptr;
    if (multi) bar = xcd_barrier_post((unsigned*)(F.ctl + 4096), F.MISC + 8);
#define SEAM(rest) do { if (multi && (pm & (rest))) xcd_barrier(bar); } while (0)

    if (pm & 1) { p0_prologue(F); SEAM(62); }
    STAMP(1);
    if (pm & 2) {
        pg8::Gemm g{F.H, F.Win_t, MT, DIN, DM}; pg8::StaticOrder S; S.init(MT, DIN, F.G, (int)blockIdx.x);
        pg8::Epi1 E{F.Qb, F.Kb, F.Vb, F.Gs, F.CU, F.BG, F.out};
        pg8::gemm_phase<pg8::Epi1, pg8::StaticOrder, true, true>(F.lds + RING_OFF, g, S, E);
        SEAM(60);
    }
    STAMP(2);
    if (pm & (4 | 64 | 128)) { const sb::Ctx C{F.Qb, F.Kb, F.Vb, F.Gs, F.MIX, F.ck, F.cv}; sb::attn_phase<SB_EARLY>(F.lds, C, F.vcu, (pm & 4) ? 3 : ((pm >> 6) & 3), F.wave, fresh_lane()); }
#if defined(PROBE_ABL)
    if (pm & 256) { const sb::Ctx C{F.Qb, F.Kb, F.Vb, F.Gs, (bf16*)(ws + WS_TMP), F.ck, F.cv}; sb::attn_phase<SB_EARLY, PROBE_ABL>(F.lds, C, F.vcu, 2, F.wave, fresh_lane()); }
#endif
    if (pm & 8) { p2_convmix(F); }
    if (pm & 12) { SEAM(48); }
    STAMP(3);
    if (pm & 16) {
        skinny_gemm2(F);
        pg8::Gemm g{F.MIX, F.Wout_t, MT, DM, DM};
        pg8::OneUnit S{F.vcu >> 3, F.vcu & 7, true};
        pg8::Epi2 E{F.xp, F.xs, F.out + O_Y};
        pg8::gemm_phase<pg8::Epi2, pg8::OneUnit, false, true>(F.lds + RING_OFF, g, S, E);
        SEAM(32);
    }
    STAMP(4);
    if (pm & 32) { final_norm_rows(F, 0, MT, F.vcu * NWAVES + F.wave, F.G * NWAVES); }
    STAMP(5);
#if defined(PROBE_TS)
    if (blockIdx.x == 0 && threadIdx.x == 0) {
        volatile LAS unsigned* tp = (volatile LAS unsigned*)(F.lds + LDSCTL_OFF + 2048);
        const unsigned long long a = ((unsigned long long)tp[2 * PROBE_TS + 1] << 32) | tp[2 * PROBE_TS], b = ((unsigned long long)tp[2 * PROBE_TS + 3] << 32) | tp[2 * PROBE_TS + 2];
        const unsigned long long d = (b - a) * 4ull, t0 = __builtin_amdgcn_s_memrealtime();
        while (__builtin_amdgcn_s_memrealtime() - t0 < d) __builtin_amdgcn_s_sleep(8);
    }
#endif
#undef SEAM
}

#ifndef NAIVE_P1
#define NAIVE_P1 0
#endif
#ifndef NAIVE_P2
#define NAIVE_P2 0
#endif
#ifndef NAIVE_P3
#define NAIVE_P3 0
#endif
#ifndef ONE_LAUNCH
#define ONE_LAUNCH 1
#endif
#if NAIVE_P1 || NAIVE_P3
__global__ void __launch_bounds__(256) gemm_naive(const bf16* A, const bf16* Bt, float* C, int M, int N, int K) {
    __shared__ float As[32][65], Bs[32][65];
    const int t = threadIdx.x, tx = t & 15, ty = t >> 4, m0 = blockIdx.y * 64, n0 = blockIdx.x * 64;
    float acc[4][4];
#pragma unroll
    for (int i = 0; i < 4; ++i)
#pragma unroll
        for (int j = 0; j < 4; ++j) acc[i][j] = 0.f;
    for (int k0 = 0; k0 < K; k0 += 32) {
        { const v4u a = *(const v4u*)(A + (size_t)(m0 + (t >> 2)) * K + k0 + (t & 3) * 8); float f[8]; unpack8(a, f);
#pragma unroll
          for (int j = 0; j < 8; ++j) As[(t & 3) * 8 + j][t >> 2] = f[j]; }
        { const v4u a = *(const v4u*)(Bt + (size_t)(n0 + (t >> 2)) * K + k0 + (t & 3) * 8); float f[8]; unpack8(a, f);
#pragma unroll
          for (int j = 0; j < 8; ++j) Bs[(t & 3) * 8 + j][t >> 2] = f[j]; }
        __syncthreads();
#pragma unroll 8
        for (int kk = 0; kk < 32; ++kk) { float a[4], b[4];
#pragma unroll
            for (int i = 0; i < 4; ++i) { a[i] = As[kk][ty * 4 + i]; b[i] = Bs[kk][tx * 4 + i]; }
#pragma unroll
            for (int i = 0; i < 4; ++i)
#pragma unroll
                for (int j = 0; j < 4; ++j) acc[i][j] += a[i] * b[j]; }
        __syncthreads();
    }
#pragma unroll
    for (int i = 0; i < 4; ++i)
#pragma unroll
        for (int j = 0; j < 4; ++j) C[(size_t)(m0 + ty * 4 + i) * N + n0 + tx * 4 + j] = acc[i][j];
}
#endif
#if NAIVE_P1
__device__ __forceinline__ unsigned short f2bf1(float f) { return (unsigned short)(cvtpk(f, 0.f) & 0xffffu); }
__global__ void __launch_bounds__(256) epi1_naive(const float* C, bf16* Qb, bf16* Kb, bf16* Vb, bf16* Gs, bf16* CU, bf16* BG, float* out) {
    const size_t gid = (size_t)blockIdx.x * 256 + threadIdx.x; if (gid >= (size_t)MT * 32 * 128) return;
    const int cc = (int)(gid & 127), pn = (int)((gid >> 7) & 31), row = (int)(gid >> 12);
    const float v0 = C[(size_t)row * DIN + 256 * pn + cc], v1 = C[(size_t)row * DIN + 256 * pn + 128 + cc];
    if (pn < 16) {
        const int typ = pn >> 2;
        for (int k = 0; k < 2; ++k) { const int col = (pn & 3) * 256 + cc + 128 * k; float v = k ? v1 : v0;
            if (typ == 0) Qb[(size_t)row * DH + col] = f2bf1(v * C2);
            else if (typ == 3) Gs[(size_t)row * DH + col] = f2bf1(v / (1.f + expf(-v)));
            else { (typ == 1 ? Kb : Vb)[(size_t)row * DH + col] = f2bf1(v);
                   out[(row < MP ? (typ == 1 ? O_KP : O_VP) + (size_t)row * DH : (typ == 1 ? O_KS : O_VS) + (size_t)(row - MP) * DH) + col] = v; } }
    } else if (pn < 24) {
        const int ch = (pn - 16) * 128 + cc; const float cu = v0 * v1; CU[(size_t)row * DH + ch] = f2bf1(cu);
        if (row < MP) { const int t = row & (SEQ - 1); if (t >= SEQ - 2) out[O_CP + (size_t)((row >> 11) * 2 + (t - (SEQ - 2))) * DH + ch] = cu; }
        else { const int r2 = row - MP, t = r2 & (DS - 1); if (t >= DS - 2) out[O_CS + (size_t)((r2 >> 5) * 2 + (t - (DS - 2))) * DH + ch] = cu; }
    } else { const int ch = (pn - 24) * 128 + cc; BG[(size_t)row * DH + ch] = f2bf1(v0 * (v1 / (1.f + expf(-v1)))); }
}
#endif
#if NAIVE_P3
__global__ void __launch_bounds__(256) epi2_naive(const float* C, const float* xp, const float* xs, float* y) {
    const size_t gid = (size_t)blockIdx.x * 256 + threadIdx.x; if (gid >= (size_t)MT * DM) return;
    const size_t row = gid / DM, col = gid % DM; const float x = row < MP ? xp[row * DM + col] : xs[(row - MP) * DM + col];
    y[gid] = x + C[gid];
}
#endif
#if NAIVE_P2
__global__ void __launch_bounds__(256) attn_naive(const bf16* Qb, const bf16* Kb, const bf16* Vb, const bf16* Gs, const float* ck, const float* cv, bf16* MIX) {
    const int gw = blockIdx.x * 4 + (threadIdx.x >> 6), lane = threadIdx.x & 63; if (gw >= MT * NH) return;
    const int row = gw >> 3, h = gw & 7, d = 2 * lane;
    const float q0 = bf2f(Qb[(size_t)row * DH + h * HD + d]), q1 = bf2f(Qb[(size_t)row * DH + h * HD + d + 1]);
    float run = 0.f, o0 = 0.f, o1 = 0.f;
    int nnew, krow0, ncache = 0, b;
    if (row < MP) { b = row >> 11; nnew = row & (SEQ - 1); krow0 = b * SEQ; } else { const int r2 = row - MP; b = r2 >> 5; nnew = r2 & (DS - 1); krow0 = MP + b * DS; ncache = PAST; }
    for (int j = nnew - 1; j >= 0; --j) {
        const size_t kr = (size_t)(krow0 + j) * DH + h * HD + d;
        float p = q0 * bf2f(Kb[kr]) + q1 * bf2f(Kb[kr + 1]);
#pragma unroll
        for (int s = 1; s < 64; s <<= 1) p += __shfl_xor(p, s);
        const float z = p, e = exp2f(-fabsf(z)), lp = log2f(1.f + e), lb = fminf(z, 0.f) - lp, l1 = fminf(-z, 0.f) - lp, w = exp2f(lb + run);
        o0 += w * bf2f(Vb[kr]); o1 += w * bf2f(Vb[kr + 1]); run += l1;
    }
    for (int j = ncache - 1; j >= 0; --j) {
        const size_t kr = ((size_t)b * PAST + j) * DH + h * HD + d;
        float p = q0 * ck[kr] + q1 * ck[kr + 1];
#pragma unroll
        for (int s = 1; s < 64; s <<= 1) p += __shfl_xor(p, s);
        const float z = p, e = exp2f(-fabsf(z)), lp = log2f(1.f + e), lb = fminf(z, 0.f) - lp, l1 = fminf(-z, 0.f) - lp, w = exp2f(lb + run);
        o0 += w * cv[kr]; o1 += w * cv[kr + 1]; run += l1;
    }
    const size_t gi = (size_t)row * DH + h * HD + d;
    const unsigned w = cvtpk(o0 * bf2f(Gs[gi]), o1 * bf2f(Gs[gi + 1]));
    *(unsigned*)(MIX + (size_t)row * DM + h * HD + d) = w;
}
#endif

extern "C" void kernel_launch(void* const* d_in, const int* in_sizes, int n_in, void* d_out, int out_size, void* d_ws, size_t ws_size, hipStream_t stream) {
    static int grid = 0;
    if (grid == 0) {
        if (n_in != 10 || (size_t)out_size != O_END || ws_size < 512 * MiB) { fprintf(stderr, "kernel_launch: unexpected sizes: n_in %d out %d ws %zu; nothing launched\n", n_in, out_size, ws_size); grid = -1; return; }
        int dev = 0, cus = 0, per_cu = 0;
        if (hipGetDevice(&dev) != hipSuccess || hipDeviceGetAttribute(&cus, hipDeviceAttributeMultiprocessorCount, dev) != hipSuccess) { grid = -1; return; }
        if (hipFuncSetAttribute((const void*)mk_fwd, hipFuncAttributeMaxDynamicSharedMemorySize, LDS_BYTES) != hipSuccess) { fprintf(stderr, "kernel_launch: hipFuncSetAttribute failed\n"); grid = -1; return; }
        if (hipOccupancyMaxActiveBlocksPerMultiprocessor(&per_cu, (const void*)mk_fwd, NWAVES * 64, LDS_BYTES) != hipSuccess || per_cu < 1) { fprintf(stderr, "kernel_launch: occupancy query says %d blocks per CU\n", per_cu); grid = -1; (void)hipGetLastError(); return; }
        if (cus != 256) { fprintf(stderr, "kernel_launch: built for a 256-CU device (one attention unit pair per workgroup), found %d CUs; nothing launched\n", cus); grid = -1; return; }
        grid = cus;
    }
    if (grid < 0) return;
    (void)hipMemsetAsync((char*)d_ws + WS_CTL, 0, CTL_ZERO_BYTES, stream);
    Args a{};
    for (int i = 0; i < 10; ++i) a.in[i] = (const float*)d_in[i];
    a.out = (float*)d_out; a.ws = (unsigned char*)d_ws;
    unsigned char* ws = (unsigned char*)d_ws;
#if ONE_LAUNCH
    a.ph_mask = 1 | 2 | 4 | 8 | 16 | 32;
    void* kargs[] = {&a};
    hipError_t e = hipLaunchCooperativeKernel((const void*)mk_fwd, dim3(grid), dim3(NWAVES * 64), kargs, LDS_BYTES, stream);
    if (e != hipSuccess) fprintf(stderr, "kernel_launch: cooperative launch failed: %s (grid %d)\n", hipGetErrorString(e), grid);
#else
#ifndef PROBE_DUP
#define PROBE_DUP 0
#endif
#define LAUNCH_PH(mask) do { a.ph_mask = (mask); for (int rep_ = 0; rep_ < ((PROBE_DUP & (mask)) == (mask) ? 2 : 1); ++rep_) hipLaunchKernelGGL(mk_fwd, dim3(grid), dim3(NWAVES * 64), LDS_BYTES, stream, a); } while (0)
    LAUNCH_PH(1);
#if NAIVE_P1
    gemm_naive<<<dim3(DIN / 64, MT / 64), 256, 0, stream>>>((const bf16*)(ws + WS_H), (const bf16*)(ws + WS_WIN), (float*)(ws + WS_TMP), MT, DIN, DM);
    epi1_naive<<<(unsigned)(((size_t)MT * 32 * 128 + 255) / 256), 256, 0, stream>>>((const float*)(ws + WS_TMP), (bf16*)(ws + WS_Q), (bf16*)(ws + WS_K), (bf16*)(ws + WS_V), (bf16*)(ws + WS_GS), (bf16*)(ws + WS_CU), (bf16*)(ws + WS_BG), (float*)d_out);
#else
    LAUNCH_PH(2);
#endif
#if NAIVE_P2
    attn_naive<<<MT * NH / 4, 256, 0, stream>>>((const bf16*)(ws + WS_Q), (const bf16*)(ws + WS_K), (const bf16*)(ws + WS_V), (const bf16*)(ws + WS_GS), (const float*)d_in[2], (const float*)d_in[3], (bf16*)(ws + WS_MIX));
    LAUNCH_PH(8);
#else
#if defined(PROBE_SPLIT_ATTN)
    LAUNCH_PH(64); LAUNCH_PH(128);
#if defined(PROBE_ABL)
    LAUNCH_PH(256);
#endif
    LAUNCH_PH(8);
#else
    LAUNCH_PH(4); LAUNCH_PH(8);
#endif
#endif
#if NAIVE_P3
    gemm_naive<<<dim3(DM / 64, MT / 64), 256, 0, stream>>>((const bf16*)(ws + WS_MIX), (const bf16*)(ws + WS_WOUT), (float*)(ws + WS_TMP), MT, DM, DM);
    epi2_naive<<<(unsigned)(((size_t)MT * DM + 255) / 256), 256, 0, stream>>>((const float*)(ws + WS_TMP), (const float*)d_in[0], (const float*)d_in[1], (float*)d_out + O_Y);
#else
    LAUNCH_PH(16);
#endif
    LAUNCH_PH(32);
#endif
    (void)ws;
}
```

```cpp
#include <hip/hip_runtime.h>
#include <cstdio>
#include <cstdint>

constexpr int DM = 2048;
constexpr int NB = 4, SEQ = 2048;
constexpr int DB = 32, DS = 32, PAST = 1024;
constexpr int MP = NB * SEQ;
constexpr int MS = DB * DS;
constexpr int MT = MP + MS;
constexpr int DIN = 8192;
constexpr int DH = 1024;
constexpr int NH = 8, HD = 128;
constexpr float EPS = 1e-6f;
constexpr float C2 = 0.08838834764831845f * 1.4426950408889634f;

constexpr size_t O_Y = 0;
constexpr size_t O_KP = (size_t)MT * DM;
constexpr size_t O_VP = O_KP + (size_t)MP * DH;
constexpr size_t O_CP = O_VP + (size_t)MP * DH;
constexpr size_t O_KS = O_CP + (size_t)NB * 2 * DH;
constexpr size_t O_VS = O_KS + (size_t)MS * DH;
constexpr size_t O_CS = O_VS + (size_t)MS * DH;
constexpr size_t O_END = O_CS + (size_t)DB * 2 * DH;

constexpr size_t MiB = 1u << 20;
constexpr size_t WS_CTL = 0, CTL_ZERO_BYTES = 1 * MiB;
constexpr size_t WS_WIN = 2 * MiB;
constexpr size_t WS_WOUT = 34 * MiB;
constexpr size_t WS_H = 42 * MiB;
constexpr size_t WS_Q = 78 * MiB, WS_K = 96 * MiB, WS_V = 114 * MiB, WS_GS = 132 * MiB, WS_CU = 150 * MiB, WS_BG = 168 * MiB;
constexpr size_t WS_MIX = 186 * MiB;
constexpr size_t WS_TMP = 224 * MiB;
constexpr size_t WS_END = 222 * MiB;

typedef unsigned short bf16;
#define GAS __attribute__((address_space(1)))
#define LAS __attribute__((address_space(3)))
#define NAIVE_P1 0
#define NAIVE_P2 0
#define NAIVE_P3 0
#define ONE_LAUNCH 1
namespace pg8 {
#define PG8_LAS __attribute__((address_space(3)))
typedef unsigned short bf16_t;
typedef short bf16x8 __attribute__((ext_vector_type(8)));
typedef float f32x4 __attribute__((ext_vector_type(4)));
typedef unsigned u32x4 __attribute__((ext_vector_type(4)));
constexpr int BM = 256, BK = 64, HALF = 128, HTB = HALF * BK * 2  , STAGE_BYTES = 8 * HTB, NXCD = 8, WGM = 8;

__host__ __device__ __forceinline__ int lds_byte(int r, int c) { const int st = (r >> 4) * 2 + (c >> 5), rr = r & 15, cc = c & 31, ob = rr * 64 + cc * 2; return st * 1024 + (ob ^ (((ob >> 9) & 1) << 5)); }
__host__ __device__ __forceinline__ void stage_rc(int b, int& R, int& C) { const int st = b / 1024, sb = b % 1024, swz = sb ^ (((sb >> 9) & 1) << 5); R = (st >> 1) * 16 + swz / 64; C = (st & 1) * 32 + (swz % 64) / 2; }
__host__ __device__ __forceinline__ int perm32(int rho) { const int n = rho >> 4, i = rho & 15; return 8 * (i >> 2) + 4 * n + (i & 3); }

struct Unit { int pm, pn; };
struct Gemm { const bf16_t* A; const bf16_t* Bt; int M, N, K; };

struct StaticOrder {
    int nM, nN, nwg, G, c;
    __host__ __device__ void init(int M, int N, int G_, int c_) { nM = M / BM; nN = N / BM; nwg = nM * nN; G = G_; c = c_; }
    __host__ __device__ bool next(int i, Unit& u) const {
        const long L = (long)i * G + c; if (L >= nwg) return false;
        int wgid = (int)L; { const int q = nwg / NXCD, r = nwg % NXCD, xcd = wgid % NXCD, off = wgid / NXCD; wgid = (xcd < r ? xcd * (q + 1) : r * (q + 1) + (xcd - r) * q) + off; }
        const int nig = WGM * nN, gid = wgid / nig, fm = gid * WGM, gsz = (nM - fm) < WGM ? (nM - fm) : WGM;
        u.pm = fm + ((wgid % nig) % gsz); u.pn = (wgid % nig) / gsz; return true;
    }
    __device__ __forceinline__ void a_ready(const Unit&) const {}
    __device__ __forceinline__ void done(const Unit&) const {}
};

typedef float f32x2_t __attribute__((ext_vector_type(2))); typedef __bf16 bf16x2_t __attribute__((ext_vector_type(2)));
__device__ __forceinline__ unsigned cvtpk(float lo, float hi) { f32x2_t v = {lo, hi}; bf16x2_t b = __builtin_convertvector(v, bf16x2_t); return __builtin_bit_cast(unsigned, b); }
__device__ __forceinline__ float silu_f(float x) { return x * __builtin_amdgcn_rcpf(1.0f + __builtin_amdgcn_exp2f(-1.4426950408889634f * x)); }
__device__ __forceinline__ f32x4 silu4(f32x4 v) { f32x4 o; o[0] = silu_f(v[0]); o[1] = silu_f(v[1]); o[2] = silu_f(v[2]); o[3] = silu_f(v[3]); return o; }

struct Epi1 {
    static constexpr bool PERM = true, AFTER_DRAIN = false;
    bf16_t *Qb, *Kb, *Vb, *Gs, *CU, *BG; float* out;
    __device__ __forceinline__ void operator()(const f32x4 (&acc)[2][2][4][2], const Unit& u, int wr, int wc, int fr, int fq) const {
        const int pn = u.pn, row0 = u.pm * BM + wr * 64 + fr, cl = wc * 32 + 8 * fq;
        if (pn < 16) {
            const int typ = pn >> 2, colb = (pn & 3) * 256 + cl;
            bf16_t* dst = typ == 0 ? Qb : (typ == 1 ? Kb : (typ == 2 ? Vb : Gs));
#pragma unroll
            for (int ai = 0; ai < 2; ++ai)
#pragma unroll
                for (int m = 0; m < 4; ++m) { const int row = row0 + ai * HALF + m * 16;
#pragma unroll
                    for (int bj = 0; bj < 2; ++bj) { const int col = colb + bj * HALF; f32x4 v0 = acc[ai][bj][m][0], v1 = acc[ai][bj][m][1];
                        if (typ == 0) { v0 = v0 * C2; v1 = v1 * C2; }
                        if (typ == 3) { v0 = silu4(v0); v1 = silu4(v1); }
                        if (typ == 1 || typ == 2) {
                            float* o = out + (row < MP ? (typ == 1 ? O_KP : O_VP) + (size_t)row * DH : (typ == 1 ? O_KS : O_VS) + (size_t)(row - MP) * DH) + col;
                            *(f32x4*)o = v0; *(f32x4*)(o + 4) = v1; }
                        u32x4 w; w.x = cvtpk(v0[0], v0[1]); w.y = cvtpk(v0[2], v0[3]); w.z = cvtpk(v1[0], v1[1]); w.w = cvtpk(v1[2], v1[3]);
                        *(u32x4*)(dst + (size_t)row * DH + col) = w; } }
        } else if (pn < 24) {
            const int chb = (pn - 16) * 128 + cl;
#pragma unroll
            for (int ai = 0; ai < 2; ++ai)
#pragma unroll
                for (int m = 0; m < 4; ++m) { const int row = row0 + ai * HALF + m * 16;
                    const f32x4 v0 = acc[ai][0][m][0] * acc[ai][1][m][0], v1 = acc[ai][0][m][1] * acc[ai][1][m][1];
                    u32x4 w; w.x = cvtpk(v0[0], v0[1]); w.y = cvtpk(v0[2], v0[3]); w.z = cvtpk(v1[0], v1[1]); w.w = cvtpk(v1[2], v1[3]);
                    *(u32x4*)(CU + (size_t)row * DH + chb) = w;
                    if (row < MP) { const int t = row & (SEQ - 1); if (t >= SEQ - 2) { float* o = out + O_CP + (size_t)((row >> 11) * 2 + (t - (SEQ - 2))) * DH + chb; *(f32x4*)o = v0; *(f32x4*)(o + 4) = v1; } }
                    else { const int r2 = row - MP, t = r2 & (DS - 1); if (t >= DS - 2) { float* o = out + O_CS + (size_t)((r2 >> 5) * 2 + (t - (DS - 2))) * DH + chb; *(f32x4*)o = v0; *(f32x4*)(o + 4) = v1; } } }
        } else {
            const int chb = (pn - 24) * 128 + cl;
#pragma unroll
            for (int ai = 0; ai < 2; ++ai)
#pragma unroll
                for (int m = 0; m < 4; ++m) { const int row = row0 + ai * HALF + m * 16;
                    const f32x4 v0 = acc[ai][0][m][0] * silu4(acc[ai][1][m][0]), v1 = acc[ai][0][m][1] * silu4(acc[ai][1][m][1]);
                    u32x4 w; w.x = cvtpk(v0[0], v0[1]); w.y = cvtpk(v0[2], v0[3]); w.z = cvtpk(v1[0], v1[1]); w.w = cvtpk(v1[2], v1[3]);
                    *(u32x4*)(BG + (size_t)row * DH + chb) = w; }
        }
    }
};
struct Epi2 {
    static constexpr bool PERM = false, AFTER_DRAIN = false;
    const float* xp; const float* xs; float* y;
    __device__ __forceinline__ void operator()(const f32x4 (&acc)[2][2][4][2], const Unit& u, int wr, int wc, int fr, int fq) const {
        const int row0 = u.pm * BM + wr * 64 + fr, col0 = u.pn * BM + wc * 32 + 4 * fq;
        const float* xb = u.pm < MP / BM ? xp + (size_t)row0 * DM : xs + (size_t)(row0 - MP) * DM; float* yb = y + (size_t)row0 * DM;
        f32x4 xr[2][2][2];
#define LDX(slot, g_) do { const int ai_ = (g_) >> 2, m_ = (g_) & 3; const float* xq = xb + (size_t)(ai_ * HALF + m_ * 16) * DM + col0; \
        _Pragma("unroll") for (int bj = 0; bj < 2; ++bj) _Pragma("unroll") for (int n = 0; n < 2; ++n) xr[slot][bj][n] = *(const f32x4*)(xq + bj * HALF + n * 16); } while (0)
        LDX(0, 0);
#pragma unroll
        for (int g = 0; g < 8; ++g) { const int ai = g >> 2, m = g & 3;
            if (g + 1 < 8) LDX((g + 1) & 1, g + 1);
            float* yq = yb + (size_t)(ai * HALF + m * 16) * DM + col0;
#pragma unroll
            for (int bj = 0; bj < 2; ++bj)
#pragma unroll
                for (int n = 0; n < 2; ++n) *(f32x4*)(yq + bj * HALF + n * 16) = acc[ai][bj][m][n] + xr[g & 1][bj][n]; }
#undef LDX
    }
};

struct OneUnit {
    int pm, pn; bool has;
    __device__ __forceinline__ bool next(int i, Unit& u) const { if (i > 0 || !has) return false; u.pm = pm; u.pn = pn; return true; }
    __device__ __forceinline__ void a_ready(const Unit&) const {}
    __device__ __forceinline__ void done(const Unit&) const {}
};

template <class Epi, class Sched, bool ALIGN_EPI = false, bool SP2 = false>
__device__ __forceinline__ void gemm_phase(PG8_LAS unsigned char* lds, const Gemm g, const Sched& S, const Epi& E) {
    const int tid = threadIdx.x, wid = __builtin_amdgcn_readfirstlane(tid >> 6), lane = tid & 63, wr = wid >> 2, wc = wid & 3, fr = lane & 15, fq = lane >> 4;
    const int K = g.K, nt = K / BK;
    unsigned voffA[2], voffB[2];
#pragma unroll
    for (int i = 0; i < 2; ++i) { int R, C; stage_rc(tid * 16 + i * 8192, R, C); const int Rb = Epi::PERM ? ((R & ~31) + perm32(R & 31)) : R;
        voffA[i] = (unsigned)(R * K + C) * 2u; voffB[i] = (unsigned)(Rb * K + C) * 2u; }
    const size_t kstep = (size_t)(BK * 2);
    const size_t hstep = (size_t)HALF * K * 2;
    const size_t tstep = 2 * hstep;
    const unsigned ldsw = (unsigned)wid * 1024u;
    const int aoff = lds_byte(wr * 64 + fr, fq * 8), boff = lds_byte(wc * 32 + fr, fq * 8);
#define PG8_SA(b, h) (((b) * 2 + (h)) * HTB)
#define PG8_SB(b, h) ((4 + (b) * 2 + (h)) * HTB)
#define PG8_STAGE(bufoff, gbase, voff) do { _Pragma("unroll") for (int _i = 0; _i < 2; ++_i) \
        __builtin_amdgcn_global_load_lds((const unsigned*)((const char*)(gbase) + (voff)[_i]), (PG8_LAS unsigned*)(lds + (bufoff) + ldsw + _i * 8192), 16, 0, 0); } while (0)
#define PG8_LDA(dst, b, h) do { _Pragma("unroll") for (int m = 0; m < 4; ++m) _Pragma("unroll") for (int k = 0; k < 2; ++k) dst[m][k] = *(const PG8_LAS bf16x8*)(lds + PG8_SA(b, h) + aoff + m * 2048 + k * 1024); } while (0)
#define PG8_LDB(dst, b, h) do { _Pragma("unroll") for (int n = 0; n < 2; ++n) _Pragma("unroll") for (int k = 0; k < 2; ++k) dst[n][k] = *(const PG8_LAS bf16x8*)(lds + PG8_SB(b, h) + boff + n * 2048 + k * 1024); } while (0)
#define PG8_MMA(ai, bj, At, Bt) do { __builtin_amdgcn_s_setprio(1); _Pragma("unroll") for (int m = 0; m < 4; ++m) _Pragma("unroll") for (int n = 0; n < 2; ++n) _Pragma("unroll") for (int k = 0; k < 2; ++k) \
        acc[ai][bj][m][n] = __builtin_amdgcn_mfma_f32_16x16x32_bf16(Bt[n][k], At[m][k], acc[ai][bj][m][n], 0, 0, 0); __builtin_amdgcn_s_setprio(0); } while (0)
#define PG8_WAIT_V(n) asm volatile("s_waitcnt vmcnt(" #n ")" ::: "memory")
#define PG8_WAIT_L(n) asm volatile("s_waitcnt lgkmcnt(" #n ")" ::: "memory")
#define PG8_BAR __builtin_amdgcn_s_barrier()
#define PG8_SCHED __builtin_amdgcn_sched_barrier(0)
    Unit cur, nxt; int ui = 0;
    if (!S.next(0, cur)) return;
    f32x4 acc[2][2][4][2];
#pragma unroll
    for (int a = 0; a < 2; ++a)
#pragma unroll
        for (int b = 0; b < 2; ++b)
#pragma unroll
            for (int m = 0; m < 4; ++m)
#pragma unroll
                for (int n = 0; n < 2; ++n) acc[a][b][m][n] = (f32x4){0.f, 0.f, 0.f, 0.f};
    bf16x8 At[4][2], B0[2][2], B1[2][2];
    const char* cA = (const char*)g.A + (size_t)cur.pm * tstep; const char* cB = (const char*)g.Bt + (size_t)cur.pn * tstep;
    S.a_ready(cur);
    if constexpr (SP2) {
        PG8_STAGE(PG8_SB(0, 0), cB, voffB); PG8_STAGE(PG8_SB(0, 1), cB + hstep, voffB); PG8_STAGE(PG8_SA(0, 0), cA, voffA); PG8_STAGE(PG8_SA(0, 1), cA + hstep, voffA);
        if (wr == 1) PG8_BAR;
        PG8_WAIT_V(2); PG8_BAR;
        PG8_STAGE(PG8_SB(1, 0), cB + kstep, voffB); PG8_STAGE(PG8_SA(1, 0), cA + kstep, voffA); PG8_STAGE(PG8_SB(1, 1), cB + hstep + kstep, voffB);
        PG8_WAIT_V(6); PG8_BAR;
    } else {
        PG8_STAGE(PG8_SB(0, 0), cB, voffB); PG8_STAGE(PG8_SA(0, 0), cA, voffA); PG8_STAGE(PG8_SB(0, 1), cB + hstep, voffB); PG8_STAGE(PG8_SA(0, 1), cA + hstep, voffA);
        if (wr == 1) PG8_BAR;
        PG8_WAIT_V(4); PG8_BAR;
        PG8_STAGE(PG8_SB(1, 0), cB + kstep, voffB); PG8_STAGE(PG8_SA(1, 0), cA + kstep, voffA); PG8_STAGE(PG8_SB(1, 1), cB + hstep + kstep, voffB);
        PG8_WAIT_V(6); PG8_BAR;
    }
    for (;;) {
        const bool has_next = S.next(ui + 1, nxt);
        const char* nA = has_next ? (const char*)g.A + (size_t)nxt.pm * tstep : cA; const char* nB = has_next ? (const char*)g.Bt + (size_t)nxt.pn * tstep : cB;
        for (int t = 0; t < nt; t += 2) {
            const bool last = (t == nt - 2);
            const char* a1 = cA + (size_t)(t + 1) * kstep;
            const char* a2 = last ? nA : cA + (size_t)(t + 2) * kstep; const char* b2 = last ? nB : cB + (size_t)(t + 2) * kstep;
            const char* a3 = a2 + kstep; const char* b3 = b2 + kstep;
            if (last && has_next) S.a_ready(nxt);
            if constexpr (SP2) {
            PG8_LDB(B0, 0, 0); PG8_LDB(B1, 0, 1); PG8_SCHED; PG8_LDA(At, 0, 0); PG8_STAGE(PG8_SA(1, 1), a1 + hstep, voffA);
            PG8_WAIT_V(8); PG8_WAIT_L(0); PG8_BAR; PG8_MMA(0, 0, At, B0); PG8_MMA(0, 1, At, B1); PG8_BAR; PG8_SCHED;
            PG8_LDA(At, 0, 1); PG8_STAGE(PG8_SB(0, 0), b2, voffB); PG8_STAGE(PG8_SB(0, 1), b2 + hstep, voffB); PG8_STAGE(PG8_SA(0, 0), a2, voffA);
            PG8_WAIT_V(8); PG8_WAIT_L(0); PG8_BAR; PG8_MMA(1, 0, At, B0); PG8_MMA(1, 1, At, B1); PG8_BAR; PG8_SCHED;
            PG8_LDB(B0, 1, 0); PG8_LDB(B1, 1, 1); PG8_SCHED; PG8_LDA(At, 1, 0); PG8_STAGE(PG8_SA(0, 1), a2 + hstep, voffA);
            PG8_WAIT_V(8); PG8_WAIT_L(0); PG8_BAR; PG8_MMA(0, 0, At, B0); PG8_MMA(0, 1, At, B1); PG8_BAR; PG8_SCHED;
            PG8_LDA(At, 1, 1); PG8_STAGE(PG8_SB(1, 0), b3, voffB); PG8_STAGE(PG8_SB(1, 1), b3 + hstep, voffB); PG8_STAGE(PG8_SA(1, 0), a3, voffA);
            PG8_WAIT_V(8); PG8_WAIT_L(0); PG8_BAR; PG8_MMA(1, 0, At, B0); PG8_MMA(1, 1, At, B1); PG8_BAR; PG8_SCHED;
            } else {
            PG8_LDB(B0, 0, 0); PG8_SCHED; PG8_LDA(At, 0, 0); PG8_STAGE(PG8_SA(1, 1), a1 + hstep, voffA);
            PG8_WAIT_L(8); PG8_BAR; PG8_WAIT_L(0); PG8_MMA(0, 0, At, B0); PG8_BAR; PG8_SCHED;
            PG8_LDB(B1, 0, 1); PG8_STAGE(PG8_SB(0, 0), b2, voffB);
            PG8_BAR; PG8_WAIT_L(0); PG8_MMA(0, 1, At, B1); PG8_BAR;
            PG8_LDA(At, 0, 1); PG8_STAGE(PG8_SA(0, 0), a2, voffA);
            PG8_BAR; PG8_WAIT_L(0); PG8_MMA(1, 0, At, B0); PG8_BAR; PG8_SCHED;
            PG8_STAGE(PG8_SB(0, 1), b2 + hstep, voffB);
            PG8_WAIT_V(6); PG8_BAR; PG8_MMA(1, 1, At, B1); PG8_BAR;
            PG8_LDB(B0, 1, 0); PG8_SCHED; PG8_LDA(At, 1, 0); PG8_STAGE(PG8_SA(0, 1), a2 + hstep, voffA);
            PG8_WAIT_L(8); PG8_BAR; PG8_WAIT_L(0); PG8_MMA(0, 0, At, B0); PG8_BAR; PG8_SCHED;
            PG8_LDB(B1, 1, 1); PG8_STAGE(PG8_SB(1, 0), b3, voffB);
            PG8_BAR; PG8_WAIT_L(0); PG8_MMA(0, 1, At, B1); PG8_BAR;
            PG8_LDA(At, 1, 1); PG8_STAGE(PG8_SA(1, 0), a3, voffA);
            PG8_BAR; PG8_WAIT_L(0); PG8_MMA(1, 0, At, B0); PG8_BAR; PG8_SCHED;
            PG8_STAGE(PG8_SB(1, 1), b3 + hstep, voffB);
            PG8_WAIT_V(6); PG8_BAR; PG8_MMA(1, 1, At, B1); PG8_BAR;
            }
        }
        if constexpr (ALIGN_EPI) { if (wr == 0) PG8_BAR; }
        if constexpr (!Epi::AFTER_DRAIN) { E(acc, cur, wr, wc, fr, fq); S.done(cur); }
        if (!has_next) break;
#pragma unroll
        for (int a = 0; a < 2; ++a)
#pragma unroll
            for (int b = 0; b < 2; ++b)
#pragma unroll
                for (int m = 0; m < 4; ++m)
#pragma unroll
                    for (int n = 0; n < 2; ++n) acc[a][b][m][n] = (f32x4){0.f, 0.f, 0.f, 0.f};
        cur = nxt; cA = nA; cB = nB; ++ui;
        if constexpr (ALIGN_EPI) { if (wr == 1) PG8_BAR; }
    }
    PG8_WAIT_V(0);
    if constexpr (!ALIGN_EPI) { if (wr == 0) PG8_BAR; }
    PG8_BAR;
    if constexpr (Epi::AFTER_DRAIN) { E.fused(acc, cur, wr, wc, fr, fq, lds, wid, lane); S.done(cur); }
#undef PG8_SA
#undef PG8_SB
#undef PG8_STAGE
#undef PG8_LDA
#undef PG8_LDB
#undef PG8_MMA
#undef PG8_WAIT_V
#undef PG8_WAIT_L
#undef PG8_BAR
#undef PG8_SCHED
}
}
constexpr int NWAVES = 8;
constexpr int RING_OFF = 0, RING_BYTES = 131072;
constexpr int LDSCTL_OFF = 155648, MISC_OFF = LDSCTL_OFF + 320;
constexpr int XCH_OFF = LDSCTL_OFF + 1024;
constexpr int CW_SAMPLE_READY = 8192;
constexpr int LDS_BYTES = 159744;
static_assert(XCH_OFF + 1024 <= LDS_BYTES && MISC_OFF + 128 <= XCH_OFF, "LDS map");

typedef unsigned v4u __attribute__((ext_vector_type(4)));
typedef unsigned v2u __attribute__((ext_vector_type(2)));
typedef float f32x4 __attribute__((ext_vector_type(4)));
typedef short bf16x8 __attribute__((ext_vector_type(8)));
typedef short s16x4 __attribute__((ext_vector_type(4)));
typedef float f32x16 __attribute__((ext_vector_type(16)));
typedef GAS unsigned gu32;
#define RLX_AGENT __ATOMIC_RELAXED, __HIP_MEMORY_SCOPE_AGENT
#define LDS_WAIT() asm volatile("s_waitcnt lgkmcnt(0)" ::: "memory")
#define VM_WAIT() asm volatile("s_waitcnt vmcnt(0)" ::: "memory")
#define CFENCE() do { asm volatile("" ::: "memory"); __builtin_amdgcn_wave_barrier(); asm volatile("" ::: "memory"); } while (0)
using pg8::cvtpk;
__device__ __forceinline__ float bf2f(unsigned b) { return __uint_as_float(b << 16); }
__device__ __forceinline__ float bflo(unsigned w) { return __uint_as_float(w << 16); }
__device__ __forceinline__ float bfhi(unsigned w) { return __uint_as_float(w & 0xffff0000u); }

#define XB_TMO      128
#define XB_XCNT(j)  (256  + 64 * (j))
#define XB_XSUB(j)  (1280 + 64 * (j))
#define XB_XGEN(j)  (2304 + 64 * (j))
#define XB_TOP      3328
#define XB_TOPGEN   3392
#define XCD_BAR_WORDS 3456
#define XB_SPIN_CAP (1u << 18)

__device__ __forceinline__ unsigned xb_ld(unsigned* p)              { return __hip_atomic_load(p, __ATOMIC_RELAXED, __HIP_MEMORY_SCOPE_AGENT); }
__device__ __forceinline__ unsigned xb_add(unsigned* p, unsigned v) { return __hip_atomic_fetch_add(p, v, __ATOMIC_RELAXED, __HIP_MEMORY_SCOPE_AGENT); }
__device__ __forceinline__ unsigned xb_xcc_id() { return (unsigned)__builtin_amdgcn_s_getreg((3 << 11) | 20) & 0xFu; }
#define XB_SPIN(cond, bar) do { unsigned _sp = 0; while (cond) { __builtin_amdgcn_s_sleep(1); \
    if ((++_sp & 255u) == 0u) { if (xb_ld(&(bar)[XB_TMO])) break; if (_sp > XB_SPIN_CAP) { atomicAdd(&(bar)[XB_TMO], 1u); break; } } } } while (0)

struct XcdBarrier {
    unsigned* bar; unsigned x;
    volatile LAS unsigned* st;
};

__device__ __forceinline__ XcdBarrier xcd_barrier_post(unsigned* bar, volatile LAS unsigned* st) {
    XcdBarrier b; b.bar = bar; b.x = xb_xcc_id(); b.st = st;
    if (threadIdx.x == 0) (void)xb_add(&bar[XB_XCNT(b.x)], 1u);
    return b;
}
__device__ __forceinline__ void xcd_barrier_complete(unsigned* bar, unsigned x, unsigned& nloc, unsigned& nx) {
    const unsigned G = gridDim.x * gridDim.y * gridDim.z;
    unsigned sum, cnt, mine, sp = 0u;
    for (;;) {
        sum = 0u; cnt = 0u; mine = 0u;
#pragma unroll
        for (unsigned j = 0; j < 16; ++j) { const unsigned c = xb_ld(&bar[XB_XCNT(j)]); sum += c; cnt += (c > 0u) ? 1u : 0u; mine = (j == x) ? c : mine; }
        if (sum == G) break;
        __builtin_amdgcn_s_sleep(1);
        if ((++sp & 255u) == 0u) { if (xb_ld(&bar[XB_TMO])) break; if (sp > XB_SPIN_CAP) { atomicAdd(&bar[XB_TMO], 1u); break; } }
    }
    nloc = mine > 0u ? mine : 1u; nx = cnt > 0u ? cnt : 1u;
}

__device__ __forceinline__ void xcd_barrier(const XcdBarrier& b) {
    asm volatile("s_waitcnt vmcnt(0)" ::: "memory");
    __syncthreads();
    if (threadIdx.x == 0) {
        unsigned* bar = b.bar;
        __builtin_amdgcn_s_waitcnt(0);
        unsigned nloc = b.st[0], nx = b.st[1];
        if (nloc == 0u) { xcd_barrier_complete(bar, b.x, nloc, nx); b.st[0] = nloc; b.st[1] = nx; }
        const unsigned old = xb_add(&bar[XB_XSUB(b.x)], 1u);
        const unsigned gen = old / nloc;
        if (old + 1u == (gen + 1u) * nloc) {
            __builtin_amdgcn_fence(__ATOMIC_RELEASE, "agent");
            asm volatile("s_waitcnt vmcnt(0)" ::: "memory");
            const unsigned og = xb_add(&bar[XB_TOP], 1u);
            const unsigned tg = og / nx;
            if (og + 1u == (tg + 1u) * nx) xb_add(&bar[XB_TOPGEN], 1u);
            else XB_SPIN(xb_ld(&bar[XB_TOPGEN]) == tg, bar);
            __builtin_amdgcn_fence(__ATOMIC_ACQUIRE, "agent");
            xb_add(&bar[XB_XGEN(b.x)], 1u);
            asm volatile("s_waitcnt vmcnt(0)" ::: "memory");
        } else {
            XB_SPIN(xb_ld(&bar[XB_XGEN(b.x)]) == gen, bar);
            __builtin_amdgcn_fence(__ATOMIC_ACQUIRE, "agent");
            asm volatile("s_waitcnt vmcnt(0)" ::: "memory");
        }
    }
    __syncthreads();
}

#if defined(PROBE_TS)
#define STAMP(i) do { if (blockIdx.x == 0 && threadIdx.x == 0) { const unsigned long long t_ = __builtin_amdgcn_s_memrealtime(); ((volatile LAS unsigned*)(F.lds + LDSCTL_OFF + 2048))[2 * (i)] = (unsigned)t_; ((volatile LAS unsigned*)(F.lds + LDSCTL_OFF + 2048))[2 * (i) + 1] = (unsigned)(t_ >> 32); } } while (0)
#define STAMP_T(i, thr) do { if (blockIdx.x == 0 && threadIdx.x == (thr)) { const unsigned long long t_ = __builtin_amdgcn_s_memrealtime(); ((volatile LAS unsigned*)(F.lds + LDSCTL_OFF + 2048))[2 * (i)] = (unsigned)t_; ((volatile LAS unsigned*)(F.lds + LDSCTL_OFF + 2048))[2 * (i) + 1] = (unsigned)(t_ >> 32); } } while (0)
#else
#define STAMP(i) do {} while (0)
#define STAMP_T(i, thr) do {} while (0)
#endif
struct Frame {
    LAS unsigned char* lds;
    volatile LAS unsigned* MISC;
    gu32* ctl;
    int wave;
    int vcu, G;
    const float *xp, *xs, *ck, *cv, *sconv, *norm_g, *w_in, *conv_w, *w_out, *final_g; float* out;
    bf16 *Win_t, *Wout_t, *H, *Qb, *Kb, *Vb, *Gs, *CU, *BG, *MIX;
};

__device__ __forceinline__ int fresh_lane() { int l; asm volatile("v_mbcnt_lo_u32_b32 %0, -1, 0\n\tv_mbcnt_hi_u32_b32 %0, -1, %0" : "=v"(l)); return l; }
__device__ __forceinline__ float wave_sum(float v) {
#pragma unroll
    for (int o = 1; o < 64; o <<= 1) v += __shfl_xor(v, o);
    return v;
}
__device__ __forceinline__ void p0_transpose_item(const float* W, int K, int N, bf16* WT, int k0, int n0, int drow0, LAS float* scr, int lane) {
    f32x4 v[8];
#pragma unroll
    for (int i = 0; i < 8; ++i) v[i] = *(const GAS f32x4*)(W + (size_t)(k0 + 8 * i + (lane >> 3)) * N + n0 + 4 * (lane & 7));
#pragma unroll
    for (int i = 0; i < 8; ++i) { LAS float* q = scr + (8 * i + (lane >> 3)) * 33 + 4 * (lane & 7); q[0] = v[i].x; q[1] = v[i].y; q[2] = v[i].z; q[3] = v[i].w; }
    LDS_WAIT(); CFENCE();
    const int c = lane & 7;
#pragma unroll
    for (int j = 0; j < 4; ++j) { const int n = (lane >> 3) + 8 * j; const LAS float* s = scr + (8 * c) * 33 + n;
        v4u o; o.x = cvtpk(s[0 * 33], s[1 * 33]); o.y = cvtpk(s[2 * 33], s[3 * 33]); o.z = cvtpk(s[4 * 33], s[5 * 33]); o.w = cvtpk(s[6 * 33], s[7 * 33]);
        *(GAS v4u*)(WT + (size_t)(drow0 + n) * K + k0 + 8 * c) = o; }
    LDS_WAIT(); CFENCE();
}
__device__ __forceinline__ int win_dest_row(int n) {
    if (n < 4096) return n;
    const int s = (n - 4096) >> 10, ch = (n - 4096) & 1023, j = ch >> 7, cc = ch & 127;
    const int tile = (s == 1 || s == 2) ? 16 + j : 24 + j, half = (s == 2 || s == 3) ? 128 : 0;
    return tile * 256 + half + cc;
}
template <int NR>
__device__ __forceinline__ void rms_rows_to_bf16(const float* const (&xrow)[NR], const float* g, bf16* const (&orow)[NR], int lane) {
    f32x4 v[NR][8]; float s[NR];
#pragma unroll
    for (int r = 0; r < NR; ++r) { const GAS f32x4* xr = (const GAS f32x4*)xrow[r] + lane;
#pragma unroll
        for (int j = 0; j < 8; ++j) v[r][j] = xr[64 * j]; }
    const GAS f32x4* gr = (const GAS f32x4*)g + lane;
#pragma unroll
    for (int r = 0; r < NR; ++r) { float a = 0.f;
#pragma unroll
        for (int j = 0; j < 8; ++j) a += (v[r][j].x * v[r][j].x + v[r][j].y * v[r][j].y) + (v[r][j].z * v[r][j].z + v[r][j].w * v[r][j].w);
        s[r] = 1.0f / sqrtf(wave_sum(a) * (1.f / DM) + EPS); }
#pragma unroll
    for (int j = 0; j < 8; ++j) { const f32x4 gg = gr[64 * j];
#pragma unroll
        for (int r = 0; r < NR; ++r) { v2u w; w.x = cvtpk((v[r][j].x * s[r]) * gg.x, (v[r][j].y * s[r]) * gg.y); w.y = cvtpk((v[r][j].z * s[r]) * gg.z, (v[r][j].w * s[r]) * gg.w);
            ((GAS v2u*)orow[r] + lane)[64 * j] = w; } }
}
__device__ __forceinline__ void p0_item_src(Frame& F, int it, const float*& W, int& N, bf16*& WT, bool& perm, int& k0, int& n0) {
    constexpr int I_IN = (DM / 64) * (DIN / 256);
    if (it < I_IN) { W = F.w_in; N = DIN; WT = F.Win_t; perm = true; k0 = 64 * (it / (DIN / 256)); n0 = 256 * (it % (DIN / 256)); }
    else { const int r = it - I_IN; W = F.w_out; N = DM; WT = F.Wout_t; perm = false; k0 = 64 * (r / (DM / 256)); n0 = 256 * (r % (DM / 256)); }
}
__device__ __forceinline__ void p0_prologue(Frame& F) {
    constexpr int NITEMS = (DM / 64) * (DIN / 256) + (DM / 64) * (DM / 256);
    const int tid = threadIdx.x, c4 = tid & 63, r = tid >> 6, lane = fresh_lane();
    LAS float* scr = (LAS float*)(F.lds + RING_OFF);
    f32x4 v[8];
    const float* W; int N; bf16* WT; bool perm; int k0, n0;
    int it = F.vcu;
    if (it < NITEMS) { p0_item_src(F, it, W, N, WT, perm, k0, n0);
#pragma unroll
        for (int i = 0; i < 8; ++i) v[i] = *(const GAS f32x4*)(W + (size_t)(k0 + r + 8 * i) * N + n0 + 4 * c4); }
    for (; it < NITEMS; it += F.G) {
        const int rot = c4 >> 3;
#pragma unroll
        for (int i = 0; i < 8; ++i) { LAS float* q = scr + (r + 8 * i) * 257 + 4 * c4;
#pragma unroll
            for (int e = 0; e < 4; ++e) { const int e2 = (e + rot) & 3; q[e2] = e2 == 0 ? v[i].x : (e2 == 1 ? v[i].y : (e2 == 2 ? v[i].z : v[i].w)); } }
        bf16* WTc = WT; const bool permc = perm; const int k0c = k0, n0c = n0;
        if (it + F.G < NITEMS) { p0_item_src(F, it + F.G, W, N, WT, perm, k0, n0);
#pragma unroll
            for (int i = 0; i < 8; ++i) v[i] = *(const GAS f32x4*)(W + (size_t)(k0 + r + 8 * i) * N + n0 + 4 * c4); }
        __syncthreads();
        const int c = tid & 7;
#pragma unroll
        for (int j = 0; j < 4; ++j) { const int n = (tid >> 3) + 64 * j; const LAS float* q = scr + (8 * c) * 257 + n;
            v4u o; o.x = cvtpk(q[0 * 257], q[1 * 257]); o.y = cvtpk(q[2 * 257], q[3 * 257]); o.z = cvtpk(q[4 * 257], q[5 * 257]); o.w = cvtpk(q[6 * 257], q[7 * 257]);
            const int drow = permc ? win_dest_row(n0c + n) : n0c + n;
            *(GAS v4u*)(WTc + (size_t)drow * DM + k0c + 8 * c) = o; }
        __syncthreads();
    }
    STAMP(6);
    const int gw = F.vcu * NWAVES + F.wave, NGW = F.G * NWAVES;
    const GAS f32x4* gr = (const GAS f32x4*)F.norm_g + lane;
    f32x4 cur[8], nxt[8];
#define XROW(m_) ((const GAS f32x4*)((m_) < MP ? F.xp + (size_t)(m_) * DM : F.xs + (size_t)((m_) - MP) * DM) + lane)
    if (gw < MT) { const GAS f32x4* xr = XROW(gw);
#pragma unroll
        for (int j = 0; j < 8; ++j) cur[j] = xr[64 * j]; }
    for (int m = gw; m < MT; m += NGW) {
        const int m2 = m + NGW;
        if (m2 < MT) { const GAS f32x4* xr = XROW(m2);
#pragma unroll
            for (int j = 0; j < 8; ++j) nxt[j] = xr[64 * j]; }
        float a = 0.f;
#pragma unroll
        for (int j = 0; j < 8; ++j) a += (cur[j].x * cur[j].x + cur[j].y * cur[j].y) + (cur[j].z * cur[j].z + cur[j].w * cur[j].w);
        const float r = 1.0f / sqrtf(wave_sum(a) * (1.f / DM) + EPS);
        GAS v2u* o8 = (GAS v2u*)(F.H + (size_t)m * DM) + lane;
#pragma unroll
        for (int j = 0; j < 8; ++j) { const f32x4 gg = gr[64 * j]; v2u w; w.x = cvtpk((cur[j].x * r) * gg.x, (cur[j].y * r) * gg.y); w.y = cvtpk((cur[j].z * r) * gg.z, (cur[j].w * r) * gg.w); o8[64 * j] = w; }
#pragma unroll
        for (int j = 0; j < 8; ++j) cur[j] = nxt[j];
    }
#undef XROW
}
__device__ __forceinline__ void final_norm_rows(Frame& F, int m0, int m1, int gw, int nw) {
    const int lane = fresh_lane();
    for (int m = m0 + gw; m < m1; m += nw) {
        GAS f32x4* yr = (GAS f32x4*)(F.out + O_Y + (size_t)m * DM) + lane; const GAS f32x4* gr = (const GAS f32x4*)F.final_g + lane;
        f32x4 v[8]; float s = 0.f;
#pragma unroll
        for (int j = 0; j < 8; ++j) { v[j] = yr[64 * j]; s += (v[j].x * v[j].x + v[j].y * v[j].y) + (v[j].z * v[j].z + v[j].w * v[j].w); }
        const float r = 1.0f / sqrtf(wave_sum(s) * (1.f / DM) + EPS);
#pragma unroll
        for (int j = 0; j < 8; ++j) { const f32x4 gg = gr[64 * j]; f32x4 o; o.x = (v[j].x * r) * gg.x; o.y = (v[j].y * r) * gg.y; o.z = (v[j].z * r) * gg.z; o.w = (v[j].w * r) * gg.w; yr[64 * j] = o; }
    }
}
__device__ __forceinline__ void unpack8(const v4u w, float (&f)[8]) { f[0] = bflo(w.x); f[1] = bfhi(w.x); f[2] = bflo(w.y); f[3] = bfhi(w.y); f[4] = bflo(w.z); f[5] = bfhi(w.z); f[6] = bflo(w.w); f[7] = bfhi(w.w); }
__device__ __forceinline__ void ld8f(const float* p, float (&f)[8]) { const f32x4 a = *(const GAS f32x4*)p, b = *(const GAS f32x4*)(p + 4); f[0] = a.x; f[1] = a.y; f[2] = a.z; f[3] = a.w; f[4] = b.x; f[5] = b.y; f[6] = b.z; f[7] = b.w; }
struct ConvIn { v4u c0, g, c1, c2; f32x4 s1a, s1b, s2a, s2b; };
__device__ __forceinline__ void conv_load(Frame& F, int row, int ch, ConvIn& I) {
    const bool samp = row >= MP; const int t = samp ? ((row - MP) & (DS - 1)) : (row & (SEQ - 1)); const int b = samp ? ((row - MP) >> 5) : 0;
    I.c0 = *(const GAS v4u*)(F.CU + (size_t)row * DH + ch); I.g = *(const GAS v4u*)(F.BG + (size_t)row * DH + ch);
    I.c1 = (v4u){0u, 0u, 0u, 0u}; I.c2 = I.c1; I.s1a = (f32x4){0.f, 0.f, 0.f, 0.f}; I.s1b = I.s1a; I.s2a = I.s1a; I.s2b = I.s1a;
    if (t >= 1) I.c1 = *(const GAS v4u*)(F.CU + (size_t)(row - 1) * DH + ch);
    else if (samp) { const float* p = F.sconv + (size_t)(b * 2 + 1) * DH + ch; I.s1a = *(const GAS f32x4*)p; I.s1b = *(const GAS f32x4*)(p + 4); }
    if (t >= 2) I.c2 = *(const GAS v4u*)(F.CU + (size_t)(row - 2) * DH + ch);
    else if (samp) { const float* p = F.sconv + (size_t)(b * 2 + t) * DH + ch; I.s2a = *(const GAS f32x4*)p; I.s2b = *(const GAS f32x4*)(p + 4); }
}
__device__ __forceinline__ void conv_store(Frame& F, int row, int ch, const ConvIn& I, const float (&w0)[8], const float (&w1)[8], const float (&w2)[8]) {
    float c0[8], c1[8], c2[8], g[8]; unpack8(I.c0, c0); unpack8(I.g, g); unpack8(I.c1, c1); unpack8(I.c2, c2);
    c1[0] += I.s1a.x; c1[1] += I.s1a.y; c1[2] += I.s1a.z; c1[3] += I.s1a.w; c1[4] += I.s1b.x; c1[5] += I.s1b.y; c1[6] += I.s1b.z; c1[7] += I.s1b.w;
    c2[0] += I.s2a.x; c2[1] += I.s2a.y; c2[2] += I.s2a.z; c2[3] += I.s2a.w; c2[4] += I.s2b.x; c2[5] += I.s2b.y; c2[6] += I.s2b.z; c2[7] += I.s2b.w;
    float o[8];
#pragma unroll
    for (int i = 0; i < 8; ++i) o[i] = g[i] * ((w0[i] * c2[i] + w1[i] * c1[i]) + w2[i] * c0[i]);
    v4u w; w.x = cvtpk(o[0], o[1]); w.y = cvtpk(o[2], o[3]); w.z = cvtpk(o[4], o[5]); w.w = cvtpk(o[6], o[7]);
    *(GAS v4u*)(F.MIX + (size_t)row * DM + DH + ch) = w;
}
__device__ __forceinline__ void p2_convmix(Frame& F, int gw, int NGW) {
    const int lane = fresh_lane();
    const int ch = (gw & 1) * 512 + lane * 8;
    float w0[8], w1[8], w2[8]; ld8f(F.conv_w + ch, w0); ld8f(F.conv_w + DH + ch, w1); ld8f(F.conv_w + 2 * DH + ch, w2);
    for (int item = gw; item < MT * 2; item += 2 * NGW) {
        const int item2 = item + NGW; ConvIn A, B;
        conv_load(F, item >> 1, ch, A);
        if (item2 < MT * 2) conv_load(F, item2 >> 1, ch, B);
        conv_store(F, item >> 1, ch, A, w0, w1, w2);
        if (item2 < MT * 2) conv_store(F, item2 >> 1, ch, B, w0, w1, w2);
    }
}

__device__ __forceinline__ void skinny_gemm2(Frame& F) {
    constexpr int PITCH = 144, ASZ = 128 * PITCH, STG = ASZ + 64 * PITCH;
    const int tid = threadIdx.x, lane = fresh_lane(), r32 = lane & 31, hi = lane >> 5, wm = F.wave >> 1, wn = F.wave & 1;
    const int mt = F.vcu >> 5, nt = F.vcu & 31;
    const bf16* A = F.MIX + (size_t)(MP + 128 * mt) * DM; const bf16* B = F.Wout_t + (size_t)(64 * nt) * DM;
    LAS char* L = (LAS char*)F.lds;
    const int arow = tid >> 3, ach = tid & 7;
    const bf16* ga = A + (size_t)arow * DM + ach * 8; const bf16* gb = B + (size_t)arow * DM + ach * 8;
    const int la = arow * PITCH + ach * 16;
    v4u ra0, ra1, rb;
#define SK_LD(kt_) do { ra0 = *(const GAS v4u*)(ga + (kt_) * 64); ra1 = *(const GAS v4u*)(ga + (size_t)64 * DM + (kt_) * 64); rb = *(const GAS v4u*)(gb + (kt_) * 64); } while (0)
#define SK_ST(st_) do { LAS char* q = L + (st_) * STG; *(LAS v4u*)(q + la) = ra0; *(LAS v4u*)(q + la + 64 * PITCH) = ra1; *(LAS v4u*)(q + ASZ + la) = rb; } while (0)
    f32x16 acc;
#pragma unroll
    for (int i = 0; i < 16; ++i) acc[i] = 0.f;
    SK_LD(0); SK_ST(0); SK_LD(1);
    __syncthreads();
    const int fa = (32 * wm + r32) * PITCH + hi * 16, fb = ASZ + (32 * wn + r32) * PITCH + hi * 16;
    for (int kt = 0; kt < DM / 64; ++kt) {
        if (kt + 1 < DM / 64) SK_ST((kt + 1) & 1);
        if (kt + 2 < DM / 64) SK_LD(kt + 2);
        LAS const char* q = L + (kt & 1) * STG;
        bf16x8 af[4], bfr[4];
#pragma unroll
        for (int s2 = 0; s2 < 4; ++s2) { af[s2] = *(LAS const bf16x8*)(q + fa + 32 * s2); bfr[s2] = *(LAS const bf16x8*)(q + fb + 32 * s2); }
#pragma unroll
        for (int s2 = 0; s2 < 4; ++s2) acc = __builtin_amdgcn_mfma_f32_32x32x16_bf16(af[s2], bfr[s2], acc, 0, 0, 0);
        __syncthreads();
    }
#undef SK_LD
#undef SK_ST
    const int col = 64 * nt + 32 * wn + r32; const int rowb = 128 * mt + 32 * wm + 4 * hi;
    float xv[16];
#pragma unroll
    for (int i = 0; i < 16; ++i) xv[i] = F.xs[(size_t)(rowb + (i & 3) + 8 * (i >> 2)) * DM + col];
#pragma unroll
    for (int i = 0; i < 16; ++i) F.out[O_Y + (size_t)(MP + rowb + (i & 3) + 8 * (i >> 2)) * DM + col] = acc[i] + xv[i];
}

namespace sb {
constexpr int KST = 272, VST = 320;
constexpr int QIMG_OFF = 32 * VST;
constexpr int ATT_REGION = 19456;
static_assert(QIMG_OFF + 32 * KST <= ATT_REGION && 8 * ATT_REGION <= LDSCTL_OFF, "attention LDS map");
typedef __amdgpu_buffer_rsrc_t rsrc_t;
__device__ __forceinline__ rsrc_t mk_rsrc(const void* p, unsigned bytes) { return __builtin_amdgcn_make_buffer_rsrc((void*)p, (short)0, (int)bytes, 0x00020000); }
__device__ __forceinline__ int crow(int r, int hi) { return (r & 3) + 8 * (r >> 2) + 4 * hi; }
__device__ __forceinline__ s16x4 vtr(LAS const char* p) { typedef short v4i16_t __attribute__((ext_vector_type(4))); return __builtin_bit_cast(s16x4, __builtin_amdgcn_ds_read_tr16_b64_v4i16((LAS v4i16_t*)p)); }

__device__ __forceinline__ void ld_bf16(v4u (&R)[8], rsrc_t rs, int soff, int lane) {
    const int voff = ((lane >> 4) * DH + (lane & 15) * 8) * 2;
#pragma unroll
    for (int i = 0; i < 8; ++i) R[i] = __builtin_bit_cast(v4u, __builtin_amdgcn_raw_buffer_load_b128(rs, voff, soff + i * (4 * DH * 2), 0));
}
__device__ __forceinline__ void st_k_bf16(LAS char* img, const v4u (&R)[8], int lane) {
    LAS char* p = img + (lane >> 4) * KST + (lane & 15) * 16;
#pragma unroll
    for (int i = 0; i < 8; ++i) *(LAS v4u*)(p + i * 4 * KST) = R[i];
}
__device__ __forceinline__ void st_v_bf16(LAS char* img, const v4u (&R)[8], int lane) {
    LAS char* p = img + (lane >> 4) * VST + (lane & 15) * 16;
#pragma unroll
    for (int i = 0; i < 8; ++i) *(LAS v4u*)(p + i * 4 * VST) = R[i];
}
__device__ __forceinline__ void ld_f32(f32x4 (&R)[16], rsrc_t rs, int soff, int lane) {
    const int voff = ((lane >> 5) * DH + (lane & 31) * 4) * 4;
#pragma unroll
    for (int i = 0; i < 16; ++i) R[i] = __builtin_bit_cast(f32x4, __builtin_amdgcn_raw_buffer_load_b128(rs, voff, soff + i * (2 * DH * 4), 0));
}
__device__ __forceinline__ void st_k_f32(LAS char* img, const f32x4 (&R)[16], int lane) {
    LAS char* p = img + (lane >> 5) * KST + (lane & 31) * 8;
#pragma unroll
    for (int i = 0; i < 16; ++i) { v2u w; w.x = cvtpk(R[i].x, R[i].y); w.y = cvtpk(R[i].z, R[i].w); *(LAS v2u*)(p + i * 2 * KST) = w; }
}
__device__ __forceinline__ void st_v_f32(LAS char* img, const f32x4 (&R)[16], int lane) {
    LAS char* p = img + (lane >> 5) * VST + (lane & 31) * 8;
#pragma unroll
    for (int i = 0; i < 16; ++i) { v2u w; w.x = cvtpk(R[i].x, R[i].y); w.y = cvtpk(R[i].z, R[i].w); *(LAS v2u*)(p + i * 2 * VST) = w; }
}
template <bool MASK>
__device__ __forceinline__ void sb_weights(const f32x16& st, float& run, bf16x8& wf0, bf16x8& wf1, int r32, int hi) {
    float be[16], ex[16], T[4];
#pragma unroll
    for (int i = 0; i < 16; ++i) { const float e = __builtin_amdgcn_exp2f(-st[i]); float bt = __builtin_amdgcn_rcpf(1.0f + e), om = 1.0f - bt;
        if (MASK) { if (crow(i, hi) >= r32) { bt = 0.f; om = 1.f; } }
        be[i] = bt; ex[i] = om; }
#pragma unroll
    for (int g = 0; g < 4; ++g) { const float l0 = ex[4 * g], l1 = ex[4 * g + 1], l2 = ex[4 * g + 2], l3 = ex[4 * g + 3];
        ex[4 * g + 3] = 1.f; ex[4 * g + 2] = l3; ex[4 * g + 1] = l3 * l2; ex[4 * g] = (l3 * l2) * l1; T[g] = ((l3 * l2) * l1) * l0; }
    float P[4], U[4];
#pragma unroll
    for (int g = 0; g < 4; ++g) { P[g] = __shfl_xor(T[g], 32); U[g] = T[g] * P[g]; }
    const float A2 = U[3], A1 = U[3] * U[2], A0 = A1 * U[1], tot = A0 * U[0];
    float off[4]; off[3] = run; off[2] = run * A2; off[1] = run * A1; off[0] = run * A0;
    if (hi == 0) {
#pragma unroll
        for (int g = 0; g < 4; ++g) off[g] *= P[g]; }
    float w[16];
#pragma unroll
    for (int i = 0; i < 16; ++i) w[i] = be[i] * (off[i >> 2] * ex[i]);
    run *= tot;
    v4u a, b; a.x = cvtpk(w[0], w[1]); a.y = cvtpk(w[2], w[3]); a.z = cvtpk(w[4], w[5]); a.w = cvtpk(w[6], w[7]);
    b.x = cvtpk(w[8], w[9]); b.y = cvtpk(w[10], w[11]); b.z = cvtpk(w[12], w[13]); b.w = cvtpk(w[14], w[15]);
    wf0 = __builtin_bit_cast(bf16x8, a); wf1 = __builtin_bit_cast(bf16x8, b);
}
template <bool MASK>
__device__ __forceinline__ void s_part(LAS const char* img, LAS const char* Qimg, float& run, bf16x8& wf0, bf16x8& wf1, int r32, int hi) {
    f32x16 st;
#pragma unroll
    for (int i = 0; i < 16; ++i) st[i] = 0.f;
    const int fo = r32 * KST + hi * 16;
#pragma unroll
    for (int s = 0; s < 8; ++s) { const bf16x8 kf = *(LAS const bf16x8*)(img + fo + 32 * s), qf = *(LAS const bf16x8*)(Qimg + fo + 32 * s); st = __builtin_amdgcn_mfma_f32_32x32x16_bf16(kf, qf, st, 0, 0, 0); }
    sb_weights<MASK>(st, run, wf0, wf1, r32, hi);
}
__device__ __forceinline__ void pv_part(LAS const char* img, f32x16 (&o)[4], const bf16x8 wf0, const bf16x8 wf1, int lane) {
    const int i = lane & 15, q4 = i >> 2, p = i & 3, hi = lane >> 5;
    LAS const char* vb = img + (4 * hi + q4) * VST + 32 * ((lane >> 4) & 1) + 8 * p;
#pragma unroll
    for (int dblk = 0; dblk < 4; ++dblk)
#pragma unroll
        for (int s = 0; s < 2; ++s) {
            const s16x4 lo = vtr(vb + 16 * s * VST + 64 * dblk), hh = vtr(vb + (16 * s + 8) * VST + 64 * dblk);
            const bf16x8 vf = (bf16x8){lo[0], lo[1], lo[2], lo[3], hh[0], hh[1], hh[2], hh[3]};
            o[dblk] = __builtin_amdgcn_mfma_f32_32x32x16_bf16(vf, s ? wf1 : wf0, o[dblk], 0, 0, 0); }
}
__device__ __forceinline__ void vfrag_load(LAS const char* img, bf16x8 (&vf)[8], int lane) {
    const int i = lane & 15, q4 = i >> 2, p = i & 3, hi = lane >> 5;
    LAS const char* vb = img + (4 * hi + q4) * VST + 32 * ((lane >> 4) & 1) + 8 * p;
#pragma unroll
    for (int dblk = 0; dblk < 4; ++dblk)
#pragma unroll
        for (int s = 0; s < 2; ++s) {
            const s16x4 lo = vtr(vb + 16 * s * VST + 64 * dblk), hh = vtr(vb + (16 * s + 8) * VST + 64 * dblk);
            vf[dblk * 2 + s] = (bf16x8){lo[0], lo[1], lo[2], lo[3], hh[0], hh[1], hh[2], hh[3]}; }
}
__device__ __forceinline__ void pv_mfma(const bf16x8 (&vf)[8], f32x16 (&o)[4], const bf16x8 wf0, const bf16x8 wf1) {
#pragma unroll
    for (int dblk = 0; dblk < 4; ++dblk) { o[dblk] = __builtin_amdgcn_mfma_f32_32x32x16_bf16(vf[dblk * 2], wf0, o[dblk], 0, 0, 0); o[dblk] = __builtin_amdgcn_mfma_f32_32x32x16_bf16(vf[dblk * 2 + 1], wf1, o[dblk], 0, 0, 0); }
}
template <bool MASK>
__device__ __forceinline__ void tile_bf16(v4u (&R)[8], rsrc_t rk, rsrc_t rv, int vo, int kno, f32x16 (&o)[4], float& run, LAS char* img, LAS char* Qimg, int lane) {
    st_k_bf16(img, R, lane);
    ld_bf16(R, rv, vo, lane);
    CFENCE();
    bf16x8 wf0, wf1;
    s_part<MASK>(img, Qimg, run, wf0, wf1, lane & 31, lane >> 5);
    CFENCE();
    st_v_bf16(img, R, lane);
    ld_bf16(R, rk, kno, lane);
    CFENCE();
    { bf16x8 vf[8]; vfrag_load(img, vf, lane); pv_mfma(vf, o, wf0, wf1); }
    CFENCE();
}
__device__ __forceinline__ void range_bf16(rsrc_t rk, rsrc_t rv, int off0, int tau_hi, int tau_lo, bool first_masked, f32x16 (&o)[4], float& run, LAS char* img, LAS char* Qimg, int lane) {
    if (tau_hi < tau_lo) return;
    constexpr int TB = 32 * DH * 2;
    v4u R[8];
    ld_bf16(R, rk, off0 + tau_hi * TB, lane);
    int tau = tau_hi;
    if (first_masked) { tile_bf16<true>(R, rk, rv, off0 + tau * TB, off0 + (tau > tau_lo ? tau - 1 : tau) * TB, o, run, img, Qimg, lane); --tau; }
    for (; tau >= tau_lo; --tau) {
        tile_bf16<false>(R, rk, rv, off0 + tau * TB, off0 + (tau > tau_lo ? tau - 1 : tau) * TB, o, run, img, Qimg, lane);
    }
}
__device__ __forceinline__ void tile_f32(f32x4 (&R)[16], rsrc_t rk, rsrc_t rv, int vo, int kno, f32x16 (&o)[4], float& run, LAS char* img, LAS char* Qimg, int lane) {
    st_k_f32(img, R, lane);
    ld_f32(R, rv, vo, lane);
    CFENCE();
    bf16x8 wf0, wf1;
    s_part<false>(img, Qimg, run, wf0, wf1, lane & 31, lane >> 5);
    CFENCE();
    st_v_f32(img, R, lane);
    ld_f32(R, rk, kno, lane);
    CFENCE();
    { bf16x8 vf[8]; vfrag_load(img, vf, lane); pv_mfma(vf, o, wf0, wf1); }
    CFENCE();
}
__device__ __forceinline__ void range_f32(rsrc_t rk, rsrc_t rv, int off0, int tau_hi, int tau_lo, f32x16 (&o)[4], float& run, LAS char* img, LAS char* Qimg, int lane) {
    if (tau_hi < tau_lo) return;
    constexpr int TB = 32 * DH * 4;
    f32x4 R[16];
    ld_f32(R, rk, off0 + tau_hi * TB, lane);
    for (int tau = tau_hi; tau >= tau_lo; --tau) {
        tile_f32(R, rk, rv, off0 + tau * TB, off0 + (tau > tau_lo ? tau - 1 : tau) * TB, o, run, img, Qimg, lane);
    }
}
__device__ __forceinline__ void load_q(LAS char* Qimg, rsrc_t rq, int soff  , int lane) {
    v4u R[8]; ld_bf16(R, rq, soff, lane); st_k_bf16(Qimg, R, lane); CFENCE();
}
__device__ __forceinline__ void zero_o(f32x16 (&o)[4]) {
#pragma unroll
    for (int d = 0; d < 4; ++d)
#pragma unroll
        for (int i = 0; i < 16; ++i) o[d][i] = 0.f;
}
__device__ __forceinline__ void epi_store(const f32x16 (&o)[4], const bf16* Gs_row, bf16* MIX_row, int hi) {
    v2u gg[16];
#pragma unroll
    for (int dblk = 0; dblk < 4; ++dblk)
#pragma unroll
        for (int g = 0; g < 4; ++g) gg[dblk * 4 + g] = *(const GAS v2u*)(Gs_row + 32 * dblk + 8 * g + 4 * hi);
#pragma unroll
    for (int dblk = 0; dblk < 4; ++dblk)
#pragma unroll
        for (int g = 0; g < 4; ++g) { const int d0 = 32 * dblk + 8 * g + 4 * hi; const v2u q = gg[dblk * 4 + g];
            v2u w; w.x = cvtpk(o[dblk][4 * g] * bflo(q.x), o[dblk][4 * g + 1] * bfhi(q.x)); w.y = cvtpk(o[dblk][4 * g + 2] * bflo(q.y), o[dblk][4 * g + 3] * bfhi(q.y));
            *(GAS v2u*)(MIX_row + d0) = w; }
}
struct Ctx { const bf16 *Qb, *Kb, *Vb, *Gs; bf16* MIX; const float *ck, *cv; };

__device__ __forceinline__ void ldq(v4u (&S)[2], rsrc_t rs, int soff, int wq, int lane) {
    const int voff = ((8 * wq + (lane >> 4)) * DH + (lane & 15) * 8) * 2;
    S[0] = __builtin_bit_cast(v4u, __builtin_amdgcn_raw_buffer_load_b128(rs, voff, soff, 0));
    S[1] = __builtin_bit_cast(v4u, __builtin_amdgcn_raw_buffer_load_b128(rs, voff, soff + 4 * DH * 2, 0));
}
__device__ __forceinline__ void stq(LAS char* img, int pitch, const v4u (&S)[2], int wq, int lane) {
    LAS char* p = img + (8 * wq + (lane >> 4)) * pitch + (lane & 15) * 16;
    *(LAS v4u*)p = S[0]; *(LAS v4u*)(p + 4 * pitch) = S[1];
}
__device__ __forceinline__ void sb_weights_rt(const f32x16& st, float& run, bf16x8& wf0, bf16x8& wf1, int r32, int hi, bool diag) {
    float be[16], ex[16], T[4];
#pragma unroll
    for (int i = 0; i < 16; ++i) { const float e = __builtin_amdgcn_exp2f(-st[i]); const float bt = __builtin_amdgcn_rcpf(1.0f + e); be[i] = bt; ex[i] = 1.0f - bt; }
    if (diag) {
#pragma unroll
        for (int i = 0; i < 16; ++i) { const bool m = crow(i, hi) >= r32; be[i] = m ? 0.f : be[i]; ex[i] = m ? 1.f : ex[i]; } }
#pragma unroll
    for (int g = 0; g < 4; ++g) { const float l0 = ex[4 * g], l1 = ex[4 * g + 1], l2 = ex[4 * g + 2], l3 = ex[4 * g + 3];
        ex[4 * g + 3] = 1.f; ex[4 * g + 2] = l3; ex[4 * g + 1] = l3 * l2; ex[4 * g] = (l3 * l2) * l1; T[g] = ((l3 * l2) * l1) * l0; }
    float P[4], U[4];
#pragma unroll
    for (int g = 0; g < 4; ++g) { P[g] = __shfl_xor(T[g], 32); U[g] = T[g] * P[g]; }
    const float A2 = U[3], A1 = U[3] * U[2], A0 = A1 * U[1], tot = A0 * U[0];
    float off[4]; off[3] = run; off[2] = run * A2; off[1] = run * A1; off[0] = run * A0;
    if (hi == 0) {
#pragma unroll
        for (int g = 0; g < 4; ++g) off[g] *= P[g]; }
    float w[16];
#pragma unroll
    for (int i = 0; i < 16; ++i) w[i] = be[i] * (off[i >> 2] * ex[i]);
    run *= tot;
    v4u a, b; a.x = cvtpk(w[0], w[1]); a.y = cvtpk(w[2], w[3]); a.z = cvtpk(w[4], w[5]); a.w = cvtpk(w[6], w[7]);
    b.x = cvtpk(w[8], w[9]); b.y = cvtpk(w[10], w[11]); b.z = cvtpk(w[12], w[13]); b.w = cvtpk(w[14], w[15]);
    wf0 = __builtin_bit_cast(bf16x8, a); wf1 = __builtin_bit_cast(bf16x8, b);
}
__device__ __forceinline__ void tile_q(LAS const char* img, LAS const char* vimg, const bf16x8 (&qf)[8], f32x16 (&o)[4], float& run, int lane, bool diag) {
    const int r32 = lane & 31, hi = lane >> 5; bf16x8 wf0, wf1;
    const int fo = r32 * KST + hi * 16;
    bf16x8 kf[8];
#pragma unroll
    for (int s = 0; s < 8; ++s) kf[s] = *(LAS const bf16x8*)(img + fo + 32 * s);
    __builtin_amdgcn_sched_barrier(0);
    f32x16 st;
#pragma unroll
    for (int i = 0; i < 16; ++i) st[i] = 0.f;
#pragma unroll
    for (int s = 0; s < 8; ++s) st = __builtin_amdgcn_mfma_f32_32x32x16_bf16(kf[s], qf[s], st, 0, 0, 0);
    bf16x8 vf[8]; vfrag_load(vimg, vf, lane);
    __builtin_amdgcn_sched_barrier(0);
    sb_weights_rt(st, run, wf0, wf1, r32, hi, diag);
    __builtin_amdgcn_sched_barrier(0);
    pv_mfma(vf, o, wf0, wf1);
}
__device__ __forceinline__ void load_qf(bf16x8 (&qf)[8], const bf16* Qrow, int hi) {
#pragma unroll
    for (int s = 0; s < 8; ++s) qf[s] = *(const GAS bf16x8*)(Qrow + 16 * s + 8 * hi);
#pragma unroll
    for (int s = 0; s < 8; ++s) asm volatile("" : "+v"(qf[s]));
}
constexpr int PG_BYTES = 2 * 32 * KST + 2 * 32 * VST;
constexpr int SAMP_OFF = 38912;
constexpr int GB_OFF = LDSCTL_OFF + 1536;
static_assert(PG_BYTES <= SAMP_OFF && SAMP_OFF + 4 * ATT_REGION <= LDSCTL_OFF, "attention LDS map");

__device__ __forceinline__ void grp_barrier(LAS unsigned* cnt, unsigned& epoch, int lane) {
    asm volatile("s_waitcnt lgkmcnt(0)" ::: "memory");
    epoch += 4u;
    if (lane == 0) __hip_atomic_fetch_add(cnt, 1u, __ATOMIC_RELAXED, __HIP_MEMORY_SCOPE_WORKGROUP);
    while (__builtin_amdgcn_readfirstlane(__hip_atomic_load(cnt, __ATOMIC_RELAXED, __HIP_MEMORY_SCOPE_WORKGROUP)) < epoch) __builtin_amdgcn_s_sleep(1);
    asm volatile("" ::: "memory");
}

constexpr int KSPLIT = 6;
constexpr int HLP_OFF = SAMP_OFF, HLP_X = SAMP_OFF + 38912;
static_assert(HLP_X + 4 * 16384 <= LDSCTL_OFF, "helper LDS map");
template <int ABL>
__device__ __forceinline__ void prompt_group(LAS unsigned char* lds, const Ctx& C, rsrc_t rK, rsrc_t rV, int unit, int wq, int lane) {
    const int r32 = lane & 31, hi = lane >> 5;
    const int bh = unit >> 3, b = bh >> 3, h = bh & 7, j = unit & 7, B = 15 - j, nA = 4 * j + 4;
    const int s0 = (b * SEQ * DH + h * HD) * 2; constexpr int TB = 32 * DH * 2; constexpr int NS = 68 - KSPLIT;
    LAS char* gb = (LAS char*)lds;
    LAS unsigned* cnt = (LAS unsigned*)((LAS char*)lds + GB_OFF); unsigned epoch = 0u;
#define KT_OF(n) ((n) < nA ? (nA - 1 - (n)) : (4 * B + 3 - ((n) - nA)))
#define KBUF(i) (gb + (i) * (32 * KST))
#define VBUF(i) (gb + 2 * 32 * KST + (i) * (32 * VST))
    int qt = 4 * j + wq;
    bf16x8 qf[8]; load_qf(qf, C.Qb + ((size_t)b * SEQ + 32 * qt + r32) * DH + h * HD, hi);
    f32x16 o[4]; zero_o(o); float run = 1.f;
    v4u KA[2], VA[2], KB2[2], VB2[2];
#define LDT(KR, VR, n_) do { const int kt_ = KT_OF(n_); ldq(KR, rK, s0 + kt_ * TB, wq, lane); ldq(VR, rV, s0 + kt_ * TB, wq, lane); } while (0)
#define STT(KR, VR, n_) do { stq(KBUF((n_) & 1), KST, KR, wq, lane); stq(VBUF((n_) & 1), VST, VR, wq, lane); } while (0)
#define STEP(n_, KR, VR) do { const int n = (n_); \
        if (n + 1 < NS) STT(KR, VR, n + 1); \
        if (n + 3 < NS) LDT(KR, VR, n + 3); \
        if (n == nA) { const size_t qrow = (size_t)b * SEQ + 32 * qt + r32; epi_store(o, C.Gs + qrow * DH + h * HD, C.MIX + qrow * DM + h * HD, hi); \
            qt = 4 * B + wq; load_qf(qf, C.Qb + ((size_t)b * SEQ + 32 * qt + r32) * DH + h * HD, hi); zero_o(o); run = 1.f; } \
        const int kt = KT_OF(n); \
        if (kt <= qt && !(ABL & 1)) tile_q(KBUF(n & 1), VBUF(n & 1), qf, o, run, lane, kt == qt); \
        grp_barrier(cnt, epoch, lane); } while (0)
    LDT(KB2, VB2, 0); STT(KB2, VB2, 0);
    LDT(KA, VA, 1); LDT(KB2, VB2, 2);
    grp_barrier(cnt, epoch, lane);
    for (int n2 = 0; n2 < NS; n2 += 2) { STEP(n2, KA, VA); STEP(n2 + 1, KB2, VB2); }
#undef LDT
#undef STT
#undef STEP
    __syncthreads();
    { LAS const float* rg = (LAS const float*)((LAS const char*)lds + HLP_X + wq * 16384);
#pragma unroll
      for (int d = 0; d < 4; ++d)
#pragma unroll
          for (int k = 0; k < 16; ++k) o[d][k] += run * rg[(d * 16 + k) * 64 + lane];
      const size_t qrow = (size_t)b * SEQ + 32 * qt + r32; epi_store(o, C.Gs + qrow * DH + h * HD, C.MIX + qrow * DM + h * HD, hi); }
#undef KT_OF
#undef KBUF
#undef VBUF
}
__device__ __forceinline__ void bold_helper(LAS unsigned char* lds, const Ctx& C, rsrc_t rK, rsrc_t rV, int unit, int w4, int lane) {
    const int r32 = lane & 31, hi = lane >> 5;
    const int bh = unit >> 3, b = bh >> 3, h = bh & 7, j = unit & 7, B = 15 - j, qt = 4 * B + w4;
    const int s0 = (b * SEQ * DH + h * HD) * 2; constexpr int TB = 32 * DH * 2; constexpr int NS = KSPLIT;
    LAS char* gb = (LAS char*)lds + HLP_OFF;
    LAS unsigned* cnt = (LAS unsigned*)((LAS char*)lds + GB_OFF + 128); unsigned epoch = 0u;
#define KT_OF(n) (NS - 1 - (n))
#define KBUF(i) (gb + (i) * (32 * KST))
#define VBUF(i) (gb + 2 * 32 * KST + (i) * (32 * VST))
    bf16x8 qf[8]; load_qf(qf, C.Qb + ((size_t)b * SEQ + 32 * qt + r32) * DH + h * HD, hi);
    f32x16 o[4]; zero_o(o); float run = 1.f;
    v4u KA[2], VA[2], KB2[2], VB2[2];
#define LDT(KR, VR, n_) do { const int kt_ = KT_OF(n_); ldq(KR, rK, s0 + kt_ * TB, w4, lane); ldq(VR, rV, s0 + kt_ * TB, w4, lane); } while (0)
#define STT(KR, VR, n_) do { stq(KBUF((n_) & 1), KST, KR, w4, lane); stq(VBUF((n_) & 1), VST, VR, w4, lane); } while (0)
#define STEP(n_, KR, VR) do { const int n = (n_); \
        if (n + 1 < NS) STT(KR, VR, n + 1); \
        if (n + 3 < NS) LDT(KR, VR, n + 3); \
        tile_q(KBUF(n & 1), VBUF(n & 1), qf, o, run, lane, false); \
        grp_barrier(cnt, epoch, lane); } while (0)
    LDT(KB2, VB2, 0); STT(KB2, VB2, 0);
    LDT(KA, VA, 1); LDT(KB2, VB2, 2);
    grp_barrier(cnt, epoch, lane);
    for (int n2 = 0; n2 < NS; n2 += 2) { STEP(n2, KA, VA); STEP(n2 + 1, KB2, VB2); }
#undef LDT
#undef STT
#undef STEP
#undef KT_OF
#undef KBUF
#undef VBUF
    LAS float* rg = (LAS float*)((LAS char*)lds + HLP_X + w4 * 16384);
#pragma unroll
    for (int d = 0; d < 4; ++d)
#pragma unroll
        for (int k = 0; k < 16; ++k) rg[(d * 16 + k) * 64 + lane] = o[d][k];
    __syncthreads();
}
__device__ __forceinline__ void sample_group(LAS unsigned char* lds, const Ctx& C, rsrc_t rQ, rsrc_t rK, rsrc_t rV, rsrc_t rCK, rsrc_t rCV, int unit, int w4, int lane) {
    LAS char* base = (LAS char*)lds + SAMP_OFF;
    LAS char* region = base + w4 * ATT_REGION; LAS char* img = region; LAS char* Qimg = region + QIMG_OFF;
    LAS float* xch = (LAS float*)((LAS char*)lds + XCH_OFF);
    LAS unsigned* cnt = (LAS unsigned*)((LAS char*)lds + GB_OFF + 64); unsigned epoch = 0u;
    const int r32 = lane & 31, hi = lane >> 5;
    const int b = unit >> 3, h = unit & 7; const size_t qrow = (size_t)MP + 32 * b + r32;
    const int new0 = ((MP + 32 * b) * DH + h * HD) * 2;
    const int c0 = (b * PAST * DH + h * HD) * 4;
    load_q(Qimg, rQ, new0, lane);
    f32x16 o[4]; zero_o(o); float run = 1.f;
    if (w4 == 3) range_bf16(rK, rV, new0, 0, 0, true, o, run, img, Qimg, lane);
    range_f32(rCK, rCV, c0, 8 * w4 + 7, 8 * w4, o, run, img, Qimg, lane);
    if (hi == 0) xch[w4 * 32 + r32] = run;
    grp_barrier(cnt, epoch, lane);
    float f = 1.f;
    for (int w2 = w4 + 1; w2 < 4; ++w2) f *= xch[w2 * 32 + r32];
    LAS float* rg = (LAS float*)region;
#pragma unroll
    for (int d = 0; d < 4; ++d)
#pragma unroll
        for (int i = 0; i < 16; ++i) rg[(d * 16 + i) * 64 + lane] = o[d][i] * f;
    grp_barrier(cnt, epoch, lane);
    float res[16];
#pragma unroll
    for (int i = 0; i < 16; ++i) { float s = 0.f;
#pragma unroll
        for (int w2 = 0; w2 < 4; ++w2) s += ((LAS const float*)(base + w2 * ATT_REGION))[(16 * w4 + i) * 64 + lane];
        res[i] = s; }
    const bf16* Gs_row = C.Gs + qrow * DH + h * HD; bf16* MIX_row = C.MIX + qrow * DM + h * HD;
    v2u gq[4];
#pragma unroll
    for (int g = 0; g < 4; ++g) gq[g] = *(const GAS v2u*)(Gs_row + 32 * w4 + 8 * g + 4 * hi);
#pragma unroll
    for (int g = 0; g < 4; ++g) { const int d0 = 32 * w4 + 8 * g + 4 * hi; const v2u gg = gq[g];
        v2u w; w.x = cvtpk(res[4 * g] * bflo(gg.x), res[4 * g + 1] * bfhi(gg.x)); w.y = cvtpk(res[4 * g + 2] * bflo(gg.y), res[4 * g + 3] * bfhi(gg.y));
        *(GAS v2u*)(MIX_row + d0) = w; }
    grp_barrier(cnt, epoch, lane);
}
template <int ABL = 0, class ConvFn>
__device__ __forceinline__ void attn_phase(LAS unsigned char* lds, const Ctx& C, int vcu, int wave, int lane, ConvFn conv) {
    const rsrc_t rQ = mk_rsrc(C.Qb, (unsigned)MT * DH * 2), rK = mk_rsrc(C.Kb, (unsigned)MT * DH * 2), rV = mk_rsrc(C.Vb, (unsigned)MT * DH * 2);
    const rsrc_t rCK = mk_rsrc(C.ck, (unsigned)DB * PAST * DH * 4), rCV = mk_rsrc(C.cv, (unsigned)DB * PAST * DH * 4);
    if (threadIdx.x < 64) ((LAS unsigned*)((LAS char*)lds + GB_OFF))[threadIdx.x] = 0u;
    __syncthreads();
    if (vcu < 256) {
        if (wave < 4) prompt_group<ABL>(lds, C, rK, rV, vcu, wave, lane);
        else { sample_group(lds, C, rQ, rK, rV, rCK, rCV, vcu, wave - 4, lane); conv(); bold_helper(lds, C, rK, rV, vcu, wave - 4, lane); }
    }
}
}

struct Args { const float* in[10]; float* out; unsigned char* ws; int ph_mask; int pad; };
__global__ void __launch_bounds__(NWAVES * 64, 2) mk_fwd(Args args) {
    extern __shared__ __attribute__((aligned(16))) unsigned char lds[];
    Frame F;
    F.lds = (LAS unsigned char*)lds;
    F.MISC = (volatile LAS unsigned*)(F.lds + MISC_OFF);
    F.wave = __builtin_amdgcn_readfirstlane(threadIdx.x >> 6);
    F.G = gridDim.x; { const int bx = blockIdx.x; F.vcu = (F.G % 8 == 0) ? (bx % 8) * (F.G / 8) + bx / 8 : bx; }
    unsigned char* ws = args.ws;
    F.ctl = (gu32*)(ws + WS_CTL);
    F.xp = args.in[0]; F.xs = args.in[1]; F.ck = args.in[2]; F.cv = args.in[3]; F.sconv = args.in[4]; F.norm_g = args.in[5]; F.w_in = args.in[6]; F.conv_w = args.in[7]; F.w_out = args.in[8]; F.final_g = args.in[9];
    F.out = args.out;
    F.Win_t = (bf16*)(ws + WS_WIN); F.Wout_t = (bf16*)(ws + WS_WOUT); F.H = (bf16*)(ws + WS_H); F.Qb = (bf16*)(ws + WS_Q); F.Kb = (bf16*)(ws + WS_K); F.Vb = (bf16*)(ws + WS_V);
    F.Gs = (bf16*)(ws + WS_GS); F.CU = (bf16*)(ws + WS_CU); F.BG = (bf16*)(ws + WS_BG); F.MIX = (bf16*)(ws + WS_MIX);
    for (int u = threadIdx.x; u < (LDS_BYTES - LDSCTL_OFF) / 4; u += NWAVES * 64) ((LAS unsigned*)(F.lds + LDSCTL_OFF))[u] = 0u;
    __syncthreads();
    STAMP(0);
    const int pm = args.ph_mask;
    const bool multi = (pm & (pm - 1)) != 0;
    XcdBarrier bar; bar.bar = (unsigned*)(F.ctl + 4096); bar.x = 0; bar.st = nullptr;
    if (multi) bar = xcd_barrier_post((unsigned*)(F.ctl + 4096), F.MISC + 8);
#define SEAM(rest) do { if (multi && (pm & (rest))) xcd_barrier(bar); } while (0)

    if (pm & 1) { p0_prologue(F); STAMP(7); SEAM(62); }
    STAMP(1);
    if (pm & 2) {
        pg8::Gemm g{F.H, F.Win_t, MT, DIN, DM}; pg8::StaticOrder S; S.init(MT, DIN, F.G, (int)blockIdx.x);
        pg8::Epi1 E{F.Qb, F.Kb, F.Vb, F.Gs, F.CU, F.BG, F.out};
        pg8::gemm_phase<pg8::Epi1, pg8::StaticOrder, true, true>(F.lds + RING_OFF, g, S, E);
        SEAM(60);
    }
    STAMP(2);
    if (pm & 4) {
        const sb::Ctx C{F.Qb, F.Kb, F.Vb, F.Gs, F.MIX, F.ck, F.cv};
        struct ConvShare { Frame& F; __device__ __forceinline__ void operator()() const { p2_convmix(F, F.vcu * 4 + (F.wave - 4), F.G * 4); } };
        sb::attn_phase<0>(F.lds, C, F.vcu, F.wave, fresh_lane(), ConvShare{F});
        STAMP_T(8, 0); STAMP_T(9, 256);
    }
    if (pm & 4) { SEAM(48); }
    STAMP(3);
    if (pm & 16) {
        skinny_gemm2(F);
        pg8::Gemm g{F.MIX, F.Wout_t, MT, DM, DM};
        pg8::OneUnit S{F.vcu >> 3, F.vcu & 7, true};
        pg8::Epi2 E{F.xp, F.xs, F.out + O_Y};
        pg8::gemm_phase<pg8::Epi2, pg8::OneUnit, false, true>(F.lds + RING_OFF, g, S, E);
        SEAM(32);
    }
    STAMP(4);
    if (pm & 32) { final_norm_rows(F, 0, MT, F.vcu * NWAVES + F.wave, F.G * NWAVES); }
    STAMP(5);
#if defined(PROBE_TS)
    if (blockIdx.x == 0 && threadIdx.x == 0) {
        volatile LAS unsigned* tp = (volatile LAS unsigned*)(F.lds + LDSCTL_OFF + 2048);
        const unsigned long long a = ((unsigned long long)tp[2 * PROBE_TS + 1] << 32) | tp[2 * PROBE_TS], b = ((unsigned long long)tp[2 * PROBE_TS_B + 1] << 32) | tp[2 * PROBE_TS_B];
        const unsigned long long d = (b - a) * 4ull, t0 = __builtin_amdgcn_s_memrealtime();
        while (__builtin_amdgcn_s_memrealtime() - t0 < d) __builtin_amdgcn_s_sleep(8);
    }
#endif
#undef SEAM
}

#ifndef NAIVE_P1
#define NAIVE_P1 0
#endif
#ifndef NAIVE_P2
#define NAIVE_P2 0
#endif
#ifndef NAIVE_P3
#define NAIVE_P3 0
#endif
#ifndef ONE_LAUNCH
#define ONE_LAUNCH 1
#endif
#if NAIVE_P1 || NAIVE_P3
__global__ void __launch_bounds__(256) gemm_naive(const bf16* A, const bf16* Bt, float* C, int M, int N, int K) {
    __shared__ float As[32][65], Bs[32][65];
    const int t = threadIdx.x, tx = t & 15, ty = t >> 4, m0 = blockIdx.y * 64, n0 = blockIdx.x * 64;
    float acc[4][4];
#pragma unroll
    for (int i = 0; i < 4; ++i)
#pragma unroll
        for (int j = 0; j < 4; ++j) acc[i][j] = 0.f;
    for (int k0 = 0; k0 < K; k0 += 32) {
        { const v4u a = *(const v4u*)(A + (size_t)(m0 + (t >> 2)) * K + k0 + (t & 3) * 8); float f[8]; unpack8(a, f);
#pragma unroll
          for (int j = 0; j < 8; ++j) As[(t & 3) * 8 + j][t >> 2] = f[j]; }
        { const v4u a = *(const v4u*)(Bt + (size_t)(n0 + (t >> 2)) * K + k0 + (t & 3) * 8); float f[8]; unpack8(a, f);
#pragma unroll
          for (int j = 0; j < 8; ++j) Bs[(t & 3) * 8 + j][t >> 2] = f[j]; }
        __syncthreads();
#pragma unroll 8
        for (int kk = 0; kk < 32; ++kk) { float a[4], b[4];
#pragma unroll
            for (int i = 0; i < 4; ++i) { a[i] = As[kk][ty * 4 + i]; b[i] = Bs[kk][tx * 4 + i]; }
#pragma unroll
            for (int i = 0; i < 4; ++i)
#pragma unroll
                for (int j = 0; j < 4; ++j) acc[i][j] += a[i] * b[j]; }
        __syncthreads();
    }
#pragma unroll
    for (int i = 0; i < 4; ++i)
#pragma unroll
        for (int j = 0; j < 4; ++j) C[(size_t)(m0 + ty * 4 + i) * N + n0 + tx * 4 + j] = acc[i][j];
}
#endif
#if NAIVE_P1
__device__ __forceinline__ unsigned short f2bf1(float f) { return (unsigned short)(cvtpk(f, 0.f) & 0xffffu); }
__global__ void __launch_bounds__(256) epi1_naive(const float* C, bf16* Qb, bf16* Kb, bf16* Vb, bf16* Gs, bf16* CU, bf16* BG, float* out) {
    const size_t gid = (size_t)blockIdx.x * 256 + threadIdx.x; if (gid >= (size_t)MT * 32 * 128) return;
    const int cc = (int)(gid & 127), pn = (int)((gid >> 7) & 31), row = (int)(gid >> 12);
    const float v0 = C[(size_t)row * DIN + 256 * pn + cc], v1 = C[(size_t)row * DIN + 256 * pn + 128 + cc];
    if (pn < 16) {
        const int typ = pn >> 2;
        for (int k = 0; k < 2; ++k) { const int col = (pn & 3) * 256 + cc + 128 * k; float v = k ? v1 : v0;
            if (typ == 0) Qb[(size_t)row * DH + col] = f2bf1(v * C2);
            else if (typ == 3) Gs[(size_t)row * DH + col] = f2bf1(v / (1.f + expf(-v)));
            else { (typ == 1 ? Kb : Vb)[(size_t)row * DH + col] = f2bf1(v);
                   out[(row < MP ? (typ == 1 ? O_KP : O_VP) + (size_t)row * DH : (typ == 1 ? O_KS : O_VS) + (size_t)(row - MP) * DH) + col] = v; } }
    } else if (pn < 24) {
        const int ch = (pn - 16) * 128 + cc; const float cu = v0 * v1; CU[(size_t)row * DH + ch] = f2bf1(cu);
        if (row < MP) { const int t = row & (SEQ - 1); if (t >= SEQ - 2) out[O_CP + (size_t)((row >> 11) * 2 + (t - (SEQ - 2))) * DH + ch] = cu; }
        else { const int r2 = row - MP, t = r2 & (DS - 1); if (t >= DS - 2) out[O_CS + (size_t)((r2 >> 5) * 2 + (t - (DS - 2))) * DH + ch] = cu; }
    } else { const int ch = (pn - 24) * 128 + cc; BG[(size_t)row * DH + ch] = f2bf1(v0 * (v1 / (1.f + expf(-v1)))); }
}
#endif
#if NAIVE_P3
__global__ void __launch_bounds__(256) epi2_naive(const float* C, const float* xp, const float* xs, float* y) {
    const size_t gid = (size_t)blockIdx.x * 256 + threadIdx.x; if (gid >= (size_t)MT * DM) return;
    const size_t row = gid / DM, col = gid % DM; const float x = row < MP ? xp[row * DM + col] : xs[(row - MP) * DM + col];
    y[gid] = x + C[gid];
}
#endif
#if NAIVE_P2
__global__ void __launch_bounds__(256) attn_naive(const bf16* Qb, const bf16* Kb, const bf16* Vb, const bf16* Gs, const float* ck, const float* cv, bf16* MIX) {
    const int gw = blockIdx.x * 4 + (threadIdx.x >> 6), lane = threadIdx.x & 63; if (gw >= MT * NH) return;
    const int row = gw >> 3, h = gw & 7, d = 2 * lane;
    const float q0 = bf2f(Qb[(size_t)row * DH + h * HD + d]), q1 = bf2f(Qb[(size_t)row * DH + h * HD + d + 1]);
    float run = 0.f, o0 = 0.f, o1 = 0.f;
    int nnew, krow0, ncache = 0, b;
    if (row < MP) { b = row >> 11; nnew = row & (SEQ - 1); krow0 = b * SEQ; } else { const int r2 = row - MP; b = r2 >> 5; nnew = r2 & (DS - 1); krow0 = MP + b * DS; ncache = PAST; }
    for (int j = nnew - 1; j >= 0; --j) {
        const size_t kr = (size_t)(krow0 + j) * DH + h * HD + d;
        float p = q0 * bf2f(Kb[kr]) + q1 * bf2f(Kb[kr + 1]);
#pragma unroll
        for (int s = 1; s < 64; s <<= 1) p += __shfl_xor(p, s);
        const float z = p, e = exp2f(-fabsf(z)), lp = log2f(1.f + e), lb = fminf(z, 0.f) - lp, l1 = fminf(-z, 0.f) - lp, w = exp2f(lb + run);
        o0 += w * bf2f(Vb[kr]); o1 += w * bf2f(Vb[kr + 1]); run += l1;
    }
    for (int j = ncache - 1; j >= 0; --j) {
        const size_t kr = ((size_t)b * PAST + j) * DH + h * HD + d;
        float p = q0 * ck[kr] + q1 * ck[kr + 1];
#pragma unroll
        for (int s = 1; s < 64; s <<= 1) p += __shfl_xor(p, s);
        const float z = p, e = exp2f(-fabsf(z)), lp = log2f(1.f + e), lb = fminf(z, 0.f) - lp, l1 = fminf(-z, 0.f) - lp, w = exp2f(lb + run);
        o0 += w * cv[kr]; o1 += w * cv[kr + 1]; run += l1;
    }
    const size_t gi = (size_t)row * DH + h * HD + d;
    const unsigned w = cvtpk(o0 * bf2f(Gs[gi]), o1 * bf2f(Gs[gi + 1]));
    *(unsigned*)(MIX + (size_t)row * DM + h * HD + d) = w;
}
#endif

extern "C" void kernel_launch(void* const* d_in, const int* in_sizes, int n_in, void* d_out, int out_size, void* d_ws, size_t ws_size, hipStream_t stream) {
    static int grid = 0;
    if (grid == 0) {
        if (n_in != 10 || (size_t)out_size != O_END || ws_size < 512 * MiB) { fprintf(stderr, "kernel_launch: unexpected sizes: n_in %d out %d ws %zu; nothing launched\n", n_in, out_size, ws_size); grid = -1; return; }
        int dev = 0, cus = 0, per_cu = 0;
        if (hipGetDevice(&dev) != hipSuccess || hipDeviceGetAttribute(&cus, hipDeviceAttributeMultiprocessorCount, dev) != hipSuccess) { grid = -1; return; }
        if (hipFuncSetAttribute((const void*)mk_fwd, hipFuncAttributeMaxDynamicSharedMemorySize, LDS_BYTES) != hipSuccess) { fprintf(stderr, "kernel_launch: hipFuncSetAttribute failed\n"); grid = -1; return; }
        if (hipOccupancyMaxActiveBlocksPerMultiprocessor(&per_cu, (const void*)mk_fwd, NWAVES * 64, LDS_BYTES) != hipSuccess || per_cu < 1) { fprintf(stderr, "kernel_launch: occupancy query says %d blocks per CU\n", per_cu); grid = -1; (void)hipGetLastError(); return; }
        if (cus != 256) { fprintf(stderr, "kernel_launch: built for a 256-CU device (one attention unit pair per workgroup), found %d CUs; nothing launched\n", cus); grid = -1; return; }
        grid = cus;
    }
    if (grid < 0) return;
    (void)hipMemsetAsync((char*)d_ws + WS_CTL, 0, CTL_ZERO_BYTES, stream);
    Args a{};
    for (int i = 0; i < 10; ++i) a.in[i] = (const float*)d_in[i];
    a.out = (float*)d_out; a.ws = (unsigned char*)d_ws;
    unsigned char* ws = (unsigned char*)d_ws;
#if ONE_LAUNCH
    a.ph_mask = 1 | 2 | 4 | 8 | 16 | 32;
    void* kargs[] = {&a};
    hipError_t e = hipLaunchCooperativeKernel((const void*)mk_fwd, dim3(grid), dim3(NWAVES * 64), kargs, LDS_BYTES, stream);
    if (e != hipSuccess) fprintf(stderr, "kernel_launch: cooperative launch failed: %s (grid %d)\n", hipGetErrorString(e), grid);
#else
#ifndef PROBE_DUP
#define PROBE_DUP 0
#endif
#define LAUNCH_PH(mask) do { a.ph_mask = (mask); for (int rep_ = 0; rep_ < ((PROBE_DUP & (mask)) == (mask) ? 2 : 1); ++rep_) hipLaunchKernelGGL(mk_fwd, dim3(grid), dim3(NWAVES * 64), LDS_BYTES, stream, a); } while (0)
    LAUNCH_PH(1);
#if NAIVE_P1
    gemm_naive<<<dim3(DIN / 64, MT / 64), 256, 0, stream>>>((const bf16*)(ws + WS_H), (const bf16*)(ws + WS_WIN), (float*)(ws + WS_TMP), MT, DIN, DM);
    epi1_naive<<<(unsigned)(((size_t)MT * 32 * 128 + 255) / 256), 256, 0, stream>>>((const float*)(ws + WS_TMP), (bf16*)(ws + WS_Q), (bf16*)(ws + WS_K), (bf16*)(ws + WS_V), (bf16*)(ws + WS_GS), (bf16*)(ws + WS_CU), (bf16*)(ws + WS_BG), (float*)d_out);
#else
    LAUNCH_PH(2);
#endif
#if NAIVE_P2
    attn_naive<<<MT * NH / 4, 256, 0, stream>>>((const bf16*)(ws + WS_Q), (const bf16*)(ws + WS_K), (const bf16*)(ws + WS_V), (const bf16*)(ws + WS_GS), (const float*)d_in[2], (const float*)d_in[3], (bf16*)(ws + WS_MIX));
    LAUNCH_PH(8);
#else
    LAUNCH_PH(4);
#endif
#if NAIVE_P3
    gemm_naive<<<dim3(DM / 64, MT / 64), 256, 0, stream>>>((const bf16*)(ws + WS_MIX), (const bf16*)(ws + WS_WOUT), (float*)(ws + WS_TMP), MT, DM, DM);
    epi2_naive<<<(unsigned)(((size_t)MT * DM + 255) / 256), 256, 0, stream>>>((const float*)(ws + WS_TMP), (const float*)d_in[0], (const float*)d_in[1], (float*)d_out + O_Y);
#else
    LAUNCH_PH(16);
#endif
    LAUNCH_PH(32);
#endif
    (void)ws;
}
```
